# Optimizing an MI355X kernel written in HIP

```python
import math
import jax, jax.numpy as jnp
from jax import lax
import numpy as np

D_MODEL = 1024
BATCH = 16
SEQ = 2048
DEPTH = 1

CHUNK = 64
Q_BLOCK = 128
MIX_WIDTH = D_MODEL
DIFF_WIDTH = MIX_WIDTH // 2
HGRN_WIDTH = MIX_WIDTH - DIFF_WIDTH
DIFF_HEAD_DIM = 64
DIFF_HEADS = DIFF_WIDTH // (2 * DIFF_HEAD_DIM)
DIFF_V_DIM = 2 * DIFF_HEAD_DIM
HGRN_EXPAND = 128
HGRN_HEADS = HGRN_WIDTH // HGRN_EXPAND
HGRN_DK = HGRN_EXPAND
HGRN_DV = HGRN_WIDTH // HGRN_HEADS
D_FF = ((8 * D_MODEL // 3 + 127) // 128) * 128
CONV_WIDTH = 3
EPS = 1e-6
IN_COLS = 3 * DIFF_WIDTH + 4 * HGRN_WIDTH

kernel_name = "hymba_diffattn_hgrn2_convffn"


def _rmsnorm(x, w):
    xf = x.astype(jnp.float32)
    y = xf * lax.rsqrt(jnp.mean(xf * xf, axis=-1, keepdims=True) + EPS)
    return (y * w.astype(jnp.float32)).astype(x.dtype)


def _lambda_init(layer):
    return 0.8 - 0.6 * math.exp(-0.3 * layer)


def _diff_attention(q, k, v, lam, lam_init, subln_w):
    B, S = q.shape[:2]
    nb = S // Q_BLOCK
    scale = DIFF_HEAD_DIM ** -0.5
    k_chunk = jnp.arange(S) // CHUNK
    q_blocks = jnp.moveaxis(q.reshape(B, nb, Q_BLOCK, DIFF_HEADS, 2, DIFF_HEAD_DIM), 1, 0)

    def block(args):
        qb, bi = args
        q_chunk = (bi * Q_BLOCK + jnp.arange(Q_BLOCK)) // CHUNK
        mask = k_chunk[None, :] <= q_chunk[:, None]
        s = jnp.einsum('bqhcd,bkhcd->bhcqk', qb, k).astype(jnp.float32) * scale
        p = jax.nn.softmax(jnp.where(mask, s, -jnp.inf), axis=-1)
        a = p[:, :, 0] - lam * p[:, :, 1]
        return jnp.einsum('bhqk,bkhe->bqhe', a.astype(v.dtype), v)

    o = lax.map(block, (q_blocks, jnp.arange(nb)))
    o = jnp.moveaxis(o, 0, 1).reshape(B, S, DIFF_HEADS, DIFF_V_DIM)
    o = _rmsnorm(o, subln_w) * (1.0 - lam_init)
    return o.reshape(B, S, DIFF_WIDTH)


def _hgrn2(q, f_logit, i, gate, lb, norm_w):
    B, S = q.shape[:2]
    nc = S // CHUNK
    f32 = jnp.float32
    f = lb + (1.0 - lb) * jax.nn.sigmoid(f_logit.astype(f32))
    log_f = jnp.log(f)
    k = 1.0 - f

    def to_chunks(t):
        return t.reshape(B, nc, CHUNK, t.shape[2], t.shape[3]).transpose(1, 0, 3, 2, 4)

    causal = jnp.tril(jnp.ones((CHUNK, CHUNK), bool))

    def step(state, xs):
        qc, kc, vc, gc = xs
        b = jnp.cumsum(gc, axis=-2)
        rel = jnp.where(causal[:, :, None],
                        b[:, :, :, None, :] - b[:, :, None, :, :], -jnp.inf)
        att = jnp.einsum('bhtk,bhsk,bhtsk->bhts', qc, kc, jnp.exp(rel))
        o = (jnp.einsum('bhts,bhsv->bhtv', att, vc)
             + jnp.einsum('bhtk,bhkv->bhtv', qc * jnp.exp(b), state))
        b_last = b[:, :, -1:, :]
        state = (jnp.exp(b_last[:, :, 0, :])[..., None] * state
                 + jnp.einsum('bhsk,bhsv->bhkv', kc * jnp.exp(b_last - b), vc))
        return state, o

    state0 = jnp.zeros((B, HGRN_HEADS, HGRN_DK, HGRN_DV), f32)
    _, o = lax.scan(step, state0, (to_chunks(q.astype(f32)), to_chunks(k),
                                   to_chunks(i.astype(f32)), to_chunks(log_f)))
    o = o.transpose(1, 0, 3, 2, 4).reshape(B, S, HGRN_HEADS, HGRN_DV)
    o = _rmsnorm(o, norm_w).reshape(B, S, HGRN_WIDTH)
    return (o * jax.nn.silu(gate.astype(f32))).astype(gate.dtype)


def _conv_ffn(x, w_up, conv_w, conv_b, w_down):
    S = x.shape[1]
    u, v = jnp.split(x @ w_up, 2, axis=-1)
    u_pad = jnp.pad(u, ((0, 0), (CONV_WIDTH - 1, 0), (0, 0)))
    c = conv_b
    for j in range(CONV_WIDTH):
        c = c + u_pad[:, j:j + S] * conv_w[j]
    return (jax.nn.silu(c) * v) @ w_down


def setup_inputs(seed: int = 0) -> dict:
    key = jax.random.key(seed)
    ks = jax.random.split(key, 20)
    n = jax.random.normal
    f32 = jnp.float32

    def gain(k, shape):
        return 1.0 + 0.02 * n(k, shape, f32)

    return {
        "x": n(ks[0], (BATCH, SEQ, D_MODEL), f32),
        "ln1_w": gain(ks[1], (DEPTH, D_MODEL)),
        "w_in": n(ks[2], (DEPTH, D_MODEL, IN_COLS), f32) * D_MODEL ** -0.5,
        "q_norm_w": gain(ks[3], (DEPTH, DIFF_HEAD_DIM)),
        "k_norm_w": gain(ks[4], (DEPTH, DIFF_HEAD_DIM)),
        "lam_q1": 0.1 * n(ks[5], (DEPTH, DIFF_HEAD_DIM), f32),
        "lam_k1": 0.1 * n(ks[6], (DEPTH, DIFF_HEAD_DIM), f32),
        "lam_q2": 0.1 * n(ks[7], (DEPTH, DIFF_HEAD_DIM), f32),
        "lam_k2": 0.1 * n(ks[8], (DEPTH, DIFF_HEAD_DIM), f32),
        "diff_subln_w": gain(ks[9], (DEPTH, DIFF_V_DIM)),
        "hgrn_lb_logits": 0.1 * n(ks[10], (DEPTH + 1, HGRN_WIDTH), f32),
        "hgrn_norm_w": gain(ks[11], (DEPTH, HGRN_DV)),
        "w_out": n(ks[12], (DEPTH, MIX_WIDTH, D_MODEL), f32) * MIX_WIDTH ** -0.5,
        "ln2_w": gain(ks[13], (DEPTH, D_MODEL)),
        "w_up": n(ks[14], (DEPTH, D_MODEL, 2 * D_FF), f32) * D_MODEL ** -0.5,
        "conv_w": n(ks[15], (DEPTH, CONV_WIDTH, D_FF), f32) * CONV_WIDTH ** -0.5,
        "conv_b": 0.02 * n(ks[16], (DEPTH, D_FF), f32),
        "w_down": n(ks[17], (DEPTH, D_FF, D_MODEL), f32) * D_FF ** -0.5,
    }


def reference(x, ln1_w, w_in, q_norm_w, k_norm_w, lam_q1, lam_k1, lam_q2, lam_k2,
              diff_subln_w, hgrn_lb_logits, hgrn_norm_w, w_out, ln2_w, w_up, conv_w,
              conv_b, w_down):
    B, S, _ = x.shape
    lb_all = jnp.cumsum(jax.nn.softmax(hgrn_lb_logits.astype(jnp.float32), axis=0), axis=0)
    offs = [DIFF_WIDTH, 2 * DIFF_WIDTH, 3 * DIFF_WIDTH,
            3 * DIFF_WIDTH + HGRN_WIDTH, 3 * DIFF_WIDTH + 2 * HGRN_WIDTH,
            3 * DIFF_WIDTH + 3 * HGRN_WIDTH]
    for l in range(DEPTH):
        h = _rmsnorm(x, ln1_w[l])
        proj = h @ w_in[l]
        dq, dk, dv, hq, hf, hi, hg = jnp.split(proj, offs, axis=-1)
        dq = _rmsnorm(dq.reshape(B, S, DIFF_HEADS, 2, DIFF_HEAD_DIM), q_norm_w[l])
        dk = _rmsnorm(dk.reshape(B, S, DIFF_HEADS, 2, DIFF_HEAD_DIM), k_norm_w[l])
        dv = dv.reshape(B, S, DIFF_HEADS, DIFF_V_DIM)
        lam_init = _lambda_init(l)
        lam = (jnp.exp(jnp.sum(lam_q1[l] * lam_k1[l]).astype(jnp.float32))
               - jnp.exp(jnp.sum(lam_q2[l] * lam_k2[l]).astype(jnp.float32)) + lam_init)
        o_diff = _diff_attention(dq, dk, dv, lam, lam_init, diff_subln_w[l])
        lb = lb_all[l].reshape(HGRN_HEADS, HGRN_DK)
        o_hgrn = _hgrn2(hq.reshape(B, S, HGRN_HEADS, HGRN_DK),
                        hf.reshape(B, S, HGRN_HEADS, HGRN_DK),
                        hi.reshape(B, S, HGRN_HEADS, HGRN_DV),
                        hg, lb, hgrn_norm_w[l])
        x = x + jnp.concatenate([o_diff, o_hgrn], axis=-1) @ w_out[l]
        x = x + _conv_ffn(_rmsnorm(x, ln2_w[l]), w_up[l], conv_w[l], conv_b[l], w_down[l])
    return x
```

```cpp
#include <hip/hip_runtime.h>
#include <hip/hip_cooperative_groups.h>
#include <stdint.h>
#include <cstdio>
namespace cg = cooperative_groups;

constexpr int D = 1024, NB = 16, S = 2048, M = NB * S;
constexpr int NH = 4, NCOLS = 3584, DFF = 2816;
constexpr int OFF_DQ = 0, OFF_DK = 512, OFF_DV = 1024, OFF_HQ = 1536, OFF_HF = 2048, OFF_HI = 2560, OFF_HG = 3072;
constexpr float EPS = 1e-6f;
constexpr float LAM_INIT = 0.2f;

namespace pg8 {
#define PG8_LAS __attribute__((address_space(3)))
typedef unsigned short bf16_t;
typedef short bf16x8 __attribute__((ext_vector_type(8)));
typedef float f32x4 __attribute__((ext_vector_type(4)));
typedef unsigned u32x4 __attribute__((ext_vector_type(4)));
constexpr int BM = 256, BK = 64, HALF = 128, HTB = HALF * BK * 2, STAGE_BYTES = 8 * HTB, NXCD = 8, WGM = 8;

__host__ __device__ __forceinline__ int lds_byte(int r, int c) { const int st = (r >> 4) * 2 + (c >> 5), rr = r & 15, cc = c & 31, ob = rr * 64 + cc * 2; return st * 1024 + (ob ^ (((ob >> 9) & 1) << 5)); }
__host__ __device__ __forceinline__ void stage_rc(int b, int& R, int& C) { const int st = b / 1024, sb = b % 1024, swz = sb ^ (((sb >> 9) & 1) << 5); R = (st >> 1) * 16 + swz / 64; C = (st & 1) * 32 + (swz % 64) / 2; }
__host__ __device__ __forceinline__ int perm32(int rho) { const int n = rho >> 4, i = rho & 15; return 8 * (i >> 2) + 4 * n + (i & 3); }

struct Unit { int pm, pn; };
struct Gemm { const bf16_t* A; const bf16_t* Bt; int M, N, K, lda; };

struct StaticOrder {
    int nM, nN, nwg, G, c;
    __host__ __device__ void init(int M_, int N_, int G_, int c_) { nM = M_ / BM; nN = N_ / BM; nwg = nM * nN; G = G_; c = c_; }
    __host__ __device__ bool next(int i, Unit& u) const {
        const long L = (long)i * G + c; if (L >= nwg) return false;
        int wgid = (int)L; { const int q = nwg / NXCD, r = nwg % NXCD, xcd = wgid % NXCD, off = wgid / NXCD; wgid = (xcd < r ? xcd * (q + 1) : r * (q + 1) + (xcd - r) * q) + off; }
        const int nig = WGM * nN, gid = wgid / nig, fm = gid * WGM, gsz = (nM - fm) < WGM ? (nM - fm) : WGM;
        u.pm = fm + ((wgid % nig) % gsz); u.pn = (wgid % nig) / gsz; return true;
    }
    __device__ __forceinline__ void a_ready(const Unit&) const {}
    __device__ __forceinline__ void done(const Unit&) const {}
};

__device__ __forceinline__ unsigned cvt_pk_bf16(float lo, float hi) { unsigned r; asm volatile("v_cvt_pk_bf16_f32 %0, %1, %2" : "=v"(r) : "v"(lo), "v"(hi)); return r; }
typedef unsigned st_u32x4 __attribute__((ext_vector_type(4)));
typedef float st_f32x4 __attribute__((ext_vector_type(4)));
__device__ __forceinline__ void st_nt(void* p, st_u32x4 v) { __builtin_nontemporal_store(v, (st_u32x4*)p); }
__device__ __forceinline__ void st_nt(void* p, st_f32x4 v) { __builtin_nontemporal_store(v, (st_f32x4*)p); }


struct EpiBf16 {
    static constexpr bool PERM = true, AFTER_DRAIN = false;
    bf16_t* O; int ldc; const float* ssq;
    __device__ __forceinline__ void operator()(const f32x4 (&acc)[2][2][4][2], const Unit& u, int wr, int wc, int fr, int fq, int ui) const {
        const int row0 = u.pm * BM + wr * 64 + fr, col0 = u.pn * BM + wc * 32 + 8 * fq;
#pragma unroll
        for (int ai = 0; ai < 2; ++ai)
#pragma unroll
            for (int m = 0; m < 4; ++m) {
                const int row = row0 + ai * HALF + m * 16;
                float sc = 1.f;
                if (ssq) { const f32x4* sp = (const f32x4*)(ssq + (size_t)row * 16); const f32x4 a = sp[0], b = sp[1], c = sp[2], d = sp[3];
                    const float s = ((a[0] + a[1]) + (a[2] + a[3])) + ((b[0] + b[1]) + (b[2] + b[3])) + ((c[0] + c[1]) + (c[2] + c[3])) + ((d[0] + d[1]) + (d[2] + d[3]));
                    sc = rsqrtf(s * (1.f / 1024.f) + EPS); }
                bf16_t* rowp = O + (size_t)row * ldc + col0;
#pragma unroll
                for (int bj = 0; bj < 2; ++bj) { const f32x4 v0 = acc[ai][bj][m][0] * sc, v1 = acc[ai][bj][m][1] * sc;
                    u32x4 w; w.x = cvt_pk_bf16(v0[0], v0[1]); w.y = cvt_pk_bf16(v0[2], v0[3]); w.z = cvt_pk_bf16(v1[0], v1[1]); w.w = cvt_pk_bf16(v1[2], v1[3]);
                    *(u32x4*)(rowp + bj * HALF) = w; }
            }
    }
};

struct EpiProj {
    static constexpr bool PERM = true, AFTER_DRAIN = false;
    bf16_t* O; const float* qw; const float* kw; float qscale; const float* lbl; float* DL; const float* hnw;
    __device__ __forceinline__ void operator()(const f32x4 (&acc)[2][2][4][2], const Unit& u, int wr, int wc, int fr, int fq, int ui) const {
        const int row0 = u.pm * BM + wr * 64 + fr;
        if (u.pn < 4) {
            const float* w = (u.pn < 2) ? qw : kw; const float sc = (u.pn < 2) ? qscale : 1.f;
            const int col0 = u.pn * BM + 64 * wc + 8 * fq;
            f32x4 wq0[2], wq1[2];
#pragma unroll
            for (int bj = 0; bj < 2; ++bj) { wq0[bj] = *(const f32x4*)(w + 32 * bj + 8 * fq); wq1[bj] = *(const f32x4*)(w + 32 * bj + 8 * fq + 4); }
            float rr[2][4];
#pragma unroll
            for (int ai = 0; ai < 2; ++ai)
#pragma unroll
                for (int m = 0; m < 4; ++m) {
                    float ss = 0.f;
#pragma unroll
                    for (int bj = 0; bj < 2; ++bj)
#pragma unroll
                        for (int n = 0; n < 2; ++n) { const f32x4 v = acc[ai][bj][m][n]; ss += (v[0] * v[0] + v[1] * v[1]) + (v[2] * v[2] + v[3] * v[3]); }
                    ss += __shfl_xor(ss, 16); ss += __shfl_xor(ss, 32);
                    rr[ai][m] = rsqrtf(ss * (1.f / 64.f) + EPS) * sc;
                }
#pragma unroll
            for (int bj = 0; bj < 2; ++bj) {
                const f32x4 w0 = wq0[bj], w1 = wq1[bj];
#pragma unroll
                for (int ai = 0; ai < 2; ++ai)
#pragma unroll
                    for (int m = 0; m < 4; ++m) {
                        const f32x4 v0 = acc[ai][bj][m][0] * rr[ai][m] * w0, v1 = acc[ai][bj][m][1] * rr[ai][m] * w1;
                        u32x4 o; o.x = cvt_pk_bf16(v0[0], v0[1]); o.y = cvt_pk_bf16(v0[2], v0[3]); o.z = cvt_pk_bf16(v1[0], v1[1]); o.w = cvt_pk_bf16(v1[2], v1[3]);
                        st_nt(O + (size_t)(row0 + ai * HALF + m * 16) * NCOLS + col0 + 32 * bj, o);
                    }
                asm volatile("" ::: "memory");
            }
        } else if (u.pn >= 6 && u.pn < 10) {
            const int h = u.pn - 6, k0 = wc * 32 + 8 * fq, lane_ = fq * 16 + fr, ad15 = (lane_ | 15) << 2;
#define EP_DPP_MUL(x, ctrl) x *= __int_as_float(__builtin_amdgcn_update_dpp(0x3f800000, __float_as_int(x), ctrl, 0xf, 0xf, false))
            f32x4 lb[2];
#pragma unroll
            for (int n = 0; n < 2; ++n) { const f32x4 l0 = *(const f32x4*)(lbl + h * 128 + k0 + 4 * n), l1 = *(const f32x4*)(lbl + 512 + h * 128 + k0 + 4 * n);
#pragma unroll
                for (int i = 0; i < 4; ++i) lb[n][i] = __builtin_amdgcn_rcpf(1.f + __builtin_amdgcn_exp2f((l1[i] - l0[i]) * 1.4426950408889634f)); }
#pragma unroll
            for (int ai = 0; ai < 2; ++ai) {
                f32x4 bc[2][4], om[2][4];
#pragma unroll
                for (int n = 0; n < 2; ++n) {
#pragma unroll
                    for (int m = 0; m < 4; ++m)
#pragma unroll
                        for (int i = 0; i < 4; ++i) {
                            const float z = acc[ai][1][m][n][i];
                            const float f = lb[n][i] + (1.f - lb[n][i]) * __builtin_amdgcn_rcpf(1.f + __builtin_amdgcn_exp2f(-1.4426950408889634f * z));
                            om[n][m][i] = 1.f - f; bc[n][m][i] = f;
                        }
#pragma unroll
                    for (int m = 0; m < 4; ++m)
#pragma unroll
                        for (int i = 0; i < 4; ++i) { EP_DPP_MUL(bc[n][m][i], 0x111); EP_DPP_MUL(bc[n][m][i], 0x112); EP_DPP_MUL(bc[n][m][i], 0x114); EP_DPP_MUL(bc[n][m][i], 0x118); }
#pragma unroll
                    for (int m = 1; m < 4; ++m)
#pragma unroll
                        for (int i = 0; i < 4; ++i) bc[n][m][i] *= __int_as_float(__builtin_amdgcn_ds_bpermute(ad15, __float_as_int(bc[n][m - 1][i])));
                }
                const int rc = u.pm * BM + ai * HALF + wr * 64;
#pragma unroll
                for (int m = 0; m < 4; ++m) {
                    unsigned wq[4], wk[4];
#pragma unroll
                    for (int n = 0; n < 2; ++n) {
                        const f32x4 q = acc[ai][0][m][n];
                        float qt[4], kt[4];
#pragma unroll
                        for (int i = 0; i < 4; ++i) { qt[i] = q[i] * bc[n][m][i]; kt[i] = om[n][m][i] * __builtin_amdgcn_rcpf(bc[n][m][i]); }
                        wq[2 * n] = cvt_pk_bf16(qt[0], qt[1]); wq[2 * n + 1] = cvt_pk_bf16(qt[2], qt[3]); wk[2 * n] = cvt_pk_bf16(kt[0], kt[1]); wk[2 * n + 1] = cvt_pk_bf16(kt[2], kt[3]);
                    }
                    bf16_t* rp = O + (size_t)(rc + m * 16 + fr) * NCOLS + h * 128 + k0;
                    st_nt(rp + OFF_HQ, (u32x4){wq[0], wq[1], wq[2], wq[3]});
                    st_nt(rp + OFF_HF, (u32x4){wk[0], wk[1], wk[2], wk[3]});
                }
                if (fr == 15) {
                    float* dp = DL + (size_t)(((rc >> 11) * 4 + h) * 32 + ((rc & 2047) >> 6)) * 128 + k0;
                    *(f32x4*)dp = bc[0][3]; *(f32x4*)(dp + 4) = bc[1][3];
                }
                asm volatile("" ::: "memory");
            }
#undef EP_DPP_MUL
        } else if (u.pn >= 12) {
            const int col0 = u.pn * BM + wc * 32 + 8 * fq;
            const f32x4 w0 = *(const f32x4*)(hnw + wc * 32 + 8 * fq), w1 = *(const f32x4*)(hnw + wc * 32 + 8 * fq + 4);
#pragma unroll
            for (int ai = 0; ai < 2; ++ai)
#pragma unroll
                for (int m = 0; m < 4; ++m) {
                    bf16_t* rowp = O + (size_t)(row0 + ai * HALF + m * 16) * NCOLS + col0;
#pragma unroll
                    for (int bj = 0; bj < 2; ++bj) { f32x4 v0 = acc[ai][bj][m][0], v1 = acc[ai][bj][m][1];
#pragma unroll
                        for (int i = 0; i < 4; ++i) { v0[i] *= w0[i] * __builtin_amdgcn_rcpf(1.f + __builtin_amdgcn_exp2f(-1.4426950408889634f * v0[i]));
                                                      v1[i] *= w1[i] * __builtin_amdgcn_rcpf(1.f + __builtin_amdgcn_exp2f(-1.4426950408889634f * v1[i])); }
                        u32x4 o; o.x = cvt_pk_bf16(v0[0], v0[1]); o.y = cvt_pk_bf16(v0[2], v0[3]); o.z = cvt_pk_bf16(v1[0], v1[1]); o.w = cvt_pk_bf16(v1[2], v1[3]);
                        st_nt(rowp + bj * HALF, o); }
                }
        } else {
            const int col0 = u.pn * BM + wc * 32 + 8 * fq;
#pragma unroll
            for (int ai = 0; ai < 2; ++ai)
#pragma unroll
                for (int m = 0; m < 4; ++m) {
                    bf16_t* rowp = O + (size_t)(row0 + ai * HALF + m * 16) * NCOLS + col0;
#pragma unroll
                    for (int bj = 0; bj < 2; ++bj) { const f32x4 v0 = acc[ai][bj][m][0], v1 = acc[ai][bj][m][1];
                        u32x4 o; o.x = cvt_pk_bf16(v0[0], v0[1]); o.y = cvt_pk_bf16(v0[2], v0[3]); o.z = cvt_pk_bf16(v1[0], v1[1]); o.w = cvt_pk_bf16(v1[2], v1[3]);
                        st_nt(rowp + bj * HALF, o); }
                }
        }
    }
};

template <bool BF16BASE, bool F32OUT, bool XBOUT, bool SCALED = false>
struct EpiResid {
    static constexpr bool PERM = true, AFTER_DRAIN = false;
    const void* base; float* out; bf16_t* xb; float* ssq; const float* rscale; const float* cw;
    __device__ __forceinline__ void operator()(const f32x4 (&acc)[2][2][4][2], const Unit& u, int wr, int wc, int fr, int fq, int ui) const {
        const int row0 = u.pm * BM + wr * 64 + fr, col0 = u.pn * BM + wc * 32 + 8 * fq;
        f32x4 ic[2][2];
        if (SCALED) {
#pragma unroll
            for (int bj = 0; bj < 2; ++bj)
#pragma unroll
                for (int n = 0; n < 2; ++n) { const f32x4 w = *(const f32x4*)(cw + col0 + bj * HALF + 4 * n); ic[bj][n] = (f32x4){__builtin_amdgcn_rcpf(w[0]), __builtin_amdgcn_rcpf(w[1]), __builtin_amdgcn_rcpf(w[2]), __builtin_amdgcn_rcpf(w[3])}; }
        }
#pragma unroll
        for (int ai = 0; ai < 2; ++ai) {
            u32x4 pb[4][2]; f32x4 pf[4][2][2]; float rsc[4];
            if (SCALED) {
#pragma unroll
                for (int m = 0; m < 4; ++m) rsc[m] = rscale[row0 + ai * HALF + m * 16];
            }
#pragma unroll
            for (int m = 0; m < 4; ++m)
#pragma unroll
                for (int bj = 0; bj < 2; ++bj) { const size_t off = (size_t)(row0 + ai * HALF + m * 16) * D + col0 + bj * HALF;
                    if (BF16BASE) pb[m][bj] = *(const u32x4*)((const bf16_t*)base + off);
                    else { pf[m][bj][0] = *(const f32x4*)((const float*)base + off); pf[m][bj][1] = *(const f32x4*)((const float*)base + off + 4); } }
#pragma unroll
            for (int m = 0; m < 4; ++m) {
                const int row = row0 + ai * HALF + m * 16; const size_t off = (size_t)row * D + col0;
                float ss = 0.f;
#pragma unroll
                for (int bj = 0; bj < 2; ++bj) {
                    f32x4 b0, b1;
                    if (BF16BASE) { const u32x4 w = pb[m][bj];
                        b0 = (f32x4){__uint_as_float(w.x << 16), __uint_as_float(w.x & 0xffff0000u), __uint_as_float(w.y << 16), __uint_as_float(w.y & 0xffff0000u)};
                        b1 = (f32x4){__uint_as_float(w.z << 16), __uint_as_float(w.z & 0xffff0000u), __uint_as_float(w.w << 16), __uint_as_float(w.w & 0xffff0000u)}; }
                    else { b0 = pf[m][bj][0]; b1 = pf[m][bj][1]; }
                    if (SCALED) { b0 = b0 * rsc[m] * ic[bj][0]; b1 = b1 * rsc[m] * ic[bj][1]; }
                    const f32x4 v0 = acc[ai][bj][m][0] + b0, v1 = acc[ai][bj][m][1] + b1;
                    if (F32OUT) { st_nt(out + off + bj * HALF, v0); st_nt(out + off + bj * HALF + 4, v1); }
                    if (XBOUT) { u32x4 w; w.x = cvt_pk_bf16(v0[0], v0[1]); w.y = cvt_pk_bf16(v0[2], v0[3]); w.z = cvt_pk_bf16(v1[0], v1[1]); w.w = cvt_pk_bf16(v1[2], v1[3]); st_nt(xb + off + bj * HALF, w);
                        ss += ((v0[0] * v0[0] + v0[1] * v0[1]) + (v0[2] * v0[2] + v0[3] * v0[3])) + ((v1[0] * v1[0] + v1[1] * v1[1]) + (v1[2] * v1[2] + v1[3] * v1[3])); }
                }
                if (XBOUT) { ss += __shfl_xor(ss, 16); ss += __shfl_xor(ss, 32); if (fq == 0) ssq[(size_t)row * 16 + u.pn * 4 + wc] = ss; }
            }
            asm volatile("" ::: "memory");
        }
    }
};

struct EpiConvGlu {
    static constexpr bool PERM = true, AFTER_DRAIN = false;
    bf16_t* G; const PG8_LAS float* rtab; const float* cw; const float* cb; float* UL; float* U01; float* V01; PG8_LAS float* hx;
    __device__ __forceinline__ void operator()(const f32x4 (&acc)[2][2][4][2], const Unit& u, int wr, int wc, int fr, int fq, int ui) const {
        const int ch0 = u.pn * HALF + wc * 32 + 8 * fq, row0 = u.pm * BM + wr * 64 + fr;
        f32x4 cbv[2], w0v[2], w1v[2], w2v[2];
#pragma unroll
        for (int n = 0; n < 2; ++n) { cbv[n] = *(const f32x4*)(cb + ch0 + 4 * n); w0v[n] = *(const f32x4*)(cw + ch0 + 4 * n); w1v[n] = *(const f32x4*)(cw + DFF + ch0 + 4 * n); w2v[n] = *(const f32x4*)(cw + 2 * DFF + ch0 + 4 * n); }
        float rs[2][4];
#pragma unroll
        for (int ai = 0; ai < 2; ++ai)
#pragma unroll
            for (int m = 0; m < 4; ++m) rs[ai][m] = rtab[ui * BM + ai * HALF + wr * 64 + m * 16 + fr];
#pragma unroll
        for (int ai = 0; ai < 2; ++ai) {
            if (fr >= 14) {
                PG8_LAS float* hp = hx + ((2 * ai + wr) * 4 + wc) * 64 + (fr - 14) * 32 + 8 * fq;
                *(PG8_LAS f32x4*)hp = acc[ai][0][3][0] * rs[ai][3]; *(PG8_LAS f32x4*)(hp + 4) = acc[ai][0][3][1] * rs[ai][3];
            }
        }
        if (wr == 1 && fr >= 14) { float* p = UL + ((size_t)u.pm * 2 + (fr - 14)) * DFF + ch0; *(f32x4*)p = acc[1][0][3][0] * rs[1][3]; *(f32x4*)(p + 4) = acc[1][0][3][1] * rs[1][3]; }
        if (wr == 0 && fr < 2) { float* p = U01 + ((size_t)u.pm * 2 + fr) * DFF + ch0; *(f32x4*)p = acc[0][0][0][0] * rs[0][0]; *(f32x4*)(p + 4) = acc[0][0][0][1] * rs[0][0];
                                 float* q = V01 + ((size_t)u.pm * 2 + fr) * DFF + ch0; *(f32x4*)q = acc[0][1][0][0] * rs[0][0]; *(f32x4*)(q + 4) = acc[0][1][0][1] * rs[0][0]; }
        asm volatile("s_waitcnt lgkmcnt(0)" ::: "memory"); __builtin_amdgcn_s_barrier(); asm volatile("" ::: "memory");
        const int lane = fq * 16 + fr;
        const bool is15 = (fr == 15), ge14 = (fr >= 14);
        typedef _Float16 h2 __attribute__((ext_vector_type(2)));
#define CG_PK(a_, b_) __builtin_bit_cast(h2, __builtin_amdgcn_cvt_pkrtz((a_), (b_)))
        const h2 mL2 = {(_Float16)-1.4426950408889634f, (_Float16)-1.4426950408889634f}, one2 = {(_Float16)1.f, (_Float16)1.f};
        h2 cb2[2][2], w02[2][2], w12[2][2], w22[2][2];
#pragma unroll
        for (int n = 0; n < 2; ++n)
#pragma unroll
            for (int p = 0; p < 2; ++p) { cb2[n][p] = CG_PK(cbv[n][2 * p], cbv[n][2 * p + 1]); w02[n][p] = CG_PK(w0v[n][2 * p], w0v[n][2 * p + 1]); w12[n][p] = CG_PK(w1v[n][2 * p], w1v[n][2 * p + 1]); w22[n][p] = CG_PK(w2v[n][2 * p], w2v[n][2 * p + 1]); }
#pragma unroll
        for (int ai = 0; ai < 2; ++ai) {
            const int gi = 2 * ai + wr;
            h2 prev[2][2];
#pragma unroll
            for (int n = 0; n < 2; ++n) {
                prev[n][0] = (h2){(_Float16)0.f, (_Float16)0.f}; prev[n][1] = prev[n][0];
                if (gi != 0) { const f32x4 pf_ = *(const PG8_LAS f32x4*)(hx + ((gi - 1) * 4 + wc) * 64 + (fr & 1) * 32 + 8 * fq + 4 * n); prev[n][0] = CG_PK(pf_[0], pf_[1]); prev[n][1] = CG_PK(pf_[2], pf_[3]); }
            }
#pragma unroll
            for (int m = 0; m < 4; ++m) {
                const float r_ = rs[ai][m]; const h2 r2 = {(_Float16)r_, (_Float16)r_};
                unsigned w[4];
#pragma unroll
                for (int n = 0; n < 2; ++n) {
                    const f32x4 uf = acc[ai][0][m][n], vf_ = acc[ai][1][m][n];
#pragma unroll
                    for (int p = 0; p < 2; ++p) {
                        const h2 cur = CG_PK(uf[2 * p], uf[2 * p + 1]) * r2;
                        const h2 vv = CG_PK(vf_[2 * p], vf_[2 * p + 1]) * r2;
                        const int ci = __builtin_bit_cast(int, cur), pi = __builtin_bit_cast(int, prev[n][p]);
                        const h2 s1 = __builtin_bit_cast(h2, __builtin_amdgcn_update_dpp(0, is15 ? pi : ci, 0x121, 0xf, 0xf, false));
                        const h2 s2 = __builtin_bit_cast(h2, __builtin_amdgcn_update_dpp(0, ge14 ? pi : ci, 0x122, 0xf, 0xf, false));
                        const h2 c = cb2[n][p] + w02[n][p] * s2 + w12[n][p] * s1 + w22[n][p] * cur;
                        const h2 t = c * mL2;
                        h2 e2; e2[0] = (_Float16)__builtin_exp2f16(t[0]); e2[1] = (_Float16)__builtin_exp2f16(t[1]);
                        const h2 d = e2 + one2;
                        h2 sg; sg[0] = (_Float16)__builtin_amdgcn_rcph(d[0]); sg[1] = (_Float16)__builtin_amdgcn_rcph(d[1]);
                        const h2 g2 = c * sg * vv;
                        w[2 * n + p] = cvt_pk_bf16((float)g2[0], (float)g2[1]);
                        prev[n][p] = cur;
                    }
                }
                st_nt(G + (size_t)(row0 + ai * HALF + m * 16) * DFF + ch0, (u32x4){w[0], w[1], w[2], w[3]});
                asm volatile("" ::: "memory");
            }
        }
#undef CG_PK
    }
};

template <class Epi, class Sched, bool ALIGN_EPI>
__device__ __forceinline__ void gemm_phase(PG8_LAS unsigned char* lds, const Gemm g, const Sched& S, const Epi& E) {
    int tid = threadIdx.x; asm volatile("" : "+v"(tid));
    const int wid = __builtin_amdgcn_readfirstlane(tid >> 6), lane = tid & 63, wr = wid >> 2, wc = wid & 3, fr = lane & 15, fq = lane >> 4;
    const int K = g.K, nt = K / BK, lda = g.lda;
    unsigned voffA[2], voffB[2];
#pragma unroll
    for (int i = 0; i < 2; ++i) { int R, C; stage_rc(tid * 16 + i * 8192, R, C); const int Rb = Epi::PERM ? ((R & ~31) + perm32(R & 31)) : R;
        voffA[i] = (unsigned)(R * lda + C) * 2u; voffB[i] = (unsigned)(Rb * K + C) * 2u; }
    const size_t kstep = (size_t)(BK * 2);
    const size_t hstepA = (size_t)HALF * lda * 2, hstepB = (size_t)HALF * K * 2;
    const size_t tstepA = 2 * hstepA, tstepB = 2 * hstepB;
    const unsigned ldsw = (unsigned)wid * 1024u;
    const int aoff = lds_byte(wr * 64 + fr, fq * 8), boff = lds_byte(wc * 32 + fr, fq * 8);
#define PG8_SA(b, h) (((b) * 2 + (h)) * HTB)
#define PG8_SB(b, h) ((4 + (b) * 2 + (h)) * HTB)
#define PG8_STAGE(bufoff, gbase, voff) do { _Pragma("unroll") for (int _i = 0; _i < 2; ++_i) \
        __builtin_amdgcn_global_load_lds((const unsigned*)((const char*)(gbase) + (voff)[_i]), (PG8_LAS unsigned*)(lds + (bufoff) + ldsw + _i * 8192), 16, 0, 0); } while (0)
#define PG8_LDA(dst, b, h) do { _Pragma("unroll") for (int m = 0; m < 4; ++m) _Pragma("unroll") for (int k = 0; k < 2; ++k) dst[m][k] = *(const PG8_LAS bf16x8*)(lds + PG8_SA(b, h) + aoff + m * 2048 + k * 1024); } while (0)
#define PG8_LDB(dst, b, h) do { _Pragma("unroll") for (int n = 0; n < 2; ++n) _Pragma("unroll") for (int k = 0; k < 2; ++k) dst[n][k] = *(const PG8_LAS bf16x8*)(lds + PG8_SB(b, h) + boff + n * 2048 + k * 1024); } while (0)
#define PG8_MMA(ai, bj, At, Bt) do { __builtin_amdgcn_s_setprio(1); _Pragma("unroll") for (int m = 0; m < 4; ++m) _Pragma("unroll") for (int n = 0; n < 2; ++n) _Pragma("unroll") for (int k = 0; k < 2; ++k) \
        acc[ai][bj][m][n] = __builtin_amdgcn_mfma_f32_16x16x32_bf16(Bt[n][k], At[m][k], acc[ai][bj][m][n], 0, 0, 0); __builtin_amdgcn_s_setprio(0); } while (0)
#define PG8_WAIT_V(n) asm volatile("s_waitcnt vmcnt(" #n ")" ::: "memory")
#define PG8_WAIT_L(n) asm volatile("s_waitcnt lgkmcnt(" #n ")" ::: "memory")
#define PG8_BAR __builtin_amdgcn_s_barrier()
#define PG8_SCHED __builtin_amdgcn_sched_barrier(0)
    Unit cur, nxt; int ui = 0;
    if (!S.next(0, cur)) return;
    f32x4 acc[2][2][4][2];
#pragma unroll
    for (int a = 0; a < 2; ++a)
#pragma unroll
        for (int b = 0; b < 2; ++b)
#pragma unroll
            for (int m = 0; m < 4; ++m)
#pragma unroll
                for (int n = 0; n < 2; ++n) acc[a][b][m][n] = (f32x4){0.f, 0.f, 0.f, 0.f};
    bf16x8 At[4][2], B0[2][2], B1[2][2];
    const char* cA = (const char*)g.A + (size_t)cur.pm * tstepA; const char* cB = (const char*)g.Bt + (size_t)cur.pn * tstepB;
    S.a_ready(cur);
    PG8_STAGE(PG8_SB(0, 0), cB, voffB); PG8_STAGE(PG8_SB(0, 1), cB + hstepB, voffB); PG8_STAGE(PG8_SA(0, 0), cA, voffA); PG8_STAGE(PG8_SA(0, 1), cA + hstepA, voffA);
    if (wr == 1) PG8_BAR;
    PG8_WAIT_V(2); PG8_BAR;
    PG8_STAGE(PG8_SB(1, 0), cB + kstep, voffB); PG8_STAGE(PG8_SA(1, 0), cA + kstep, voffA); PG8_STAGE(PG8_SB(1, 1), cB + hstepB + kstep, voffB);
    PG8_WAIT_V(6); PG8_BAR;
    for (;;) {
        const bool has_next = S.next(ui + 1, nxt);
        const char* nA = has_next ? (const char*)g.A + (size_t)nxt.pm * tstepA : cA; const char* nB = has_next ? (const char*)g.Bt + (size_t)nxt.pn * tstepB : cB;
        for (int t = 0; t < nt; t += 2) {
            const bool last = (t == nt - 2);
            const char* a1 = cA + (size_t)(t + 1) * kstep;
            const char* a2 = last ? nA : cA + (size_t)(t + 2) * kstep; const char* b2 = last ? nB : cB + (size_t)(t + 2) * kstep;
            const char* a3 = a2 + kstep; const char* b3 = b2 + kstep;
            if (last && has_next) S.a_ready(nxt);
            PG8_LDB(B0, 0, 0); PG8_LDB(B1, 0, 1); PG8_SCHED; PG8_LDA(At, 0, 0); PG8_STAGE(PG8_SA(1, 1), a1 + hstepA, voffA);
            PG8_WAIT_V(8); PG8_WAIT_L(0); PG8_BAR; PG8_MMA(0, 0, At, B0); PG8_MMA(0, 1, At, B1); PG8_BAR; PG8_SCHED;
            PG8_LDA(At, 0, 1); PG8_STAGE(PG8_SB(0, 0), b2, voffB); PG8_STAGE(PG8_SB(0, 1), b2 + hstepB, voffB); PG8_STAGE(PG8_SA(0, 0), a2, voffA);
            PG8_WAIT_V(8); PG8_WAIT_L(0); PG8_BAR; PG8_MMA(1, 0, At, B0); PG8_MMA(1, 1, At, B1); PG8_BAR; PG8_SCHED;
            PG8_LDB(B0, 1, 0); PG8_LDB(B1, 1, 1); PG8_SCHED; PG8_LDA(At, 1, 0); PG8_STAGE(PG8_SA(0, 1), a2 + hstepA, voffA);
            PG8_WAIT_V(8); PG8_WAIT_L(0); PG8_BAR; PG8_MMA(0, 0, At, B0); PG8_MMA(0, 1, At, B1); PG8_BAR; PG8_SCHED;
            PG8_LDA(At, 1, 1); PG8_STAGE(PG8_SB(1, 0), b3, voffB); PG8_STAGE(PG8_SB(1, 1), b3 + hstepB, voffB); PG8_STAGE(PG8_SA(1, 0), a3, voffA);
            PG8_WAIT_V(8); PG8_WAIT_L(0); PG8_BAR; PG8_MMA(1, 0, At, B0); PG8_MMA(1, 1, At, B1); PG8_BAR; PG8_SCHED;
        }
        if constexpr (ALIGN_EPI) { if (wr == 0) PG8_BAR; }
        E(acc, cur, wr, wc, fr, fq, ui); S.done(cur);
        if (!has_next) break;
#pragma unroll
        for (int a = 0; a < 2; ++a)
#pragma unroll
            for (int b = 0; b < 2; ++b)
#pragma unroll
                for (int m = 0; m < 4; ++m)
#pragma unroll
                    for (int n = 0; n < 2; ++n) acc[a][b][m][n] = (f32x4){0.f, 0.f, 0.f, 0.f};
        cur = nxt; cA = nA; cB = nB; ++ui;
        if constexpr (ALIGN_EPI) { if (wr == 1) PG8_BAR; }
    }
    PG8_WAIT_V(0);
    if constexpr (!ALIGN_EPI) { if (wr == 0) PG8_BAR; }
    PG8_BAR;
#undef PG8_SA
#undef PG8_SB
#undef PG8_STAGE
#undef PG8_LDA
#undef PG8_LDB
#undef PG8_MMA
#undef PG8_WAIT_V
#undef PG8_WAIT_L
#undef PG8_BAR
#undef PG8_SCHED
}
}

#define LAS __attribute__((address_space(3)))
typedef unsigned short bf16_t;
typedef float f32x4 __attribute__((ext_vector_type(4)));
typedef unsigned u32x4 __attribute__((ext_vector_type(4)));
typedef unsigned u32x2 __attribute__((ext_vector_type(2)));
constexpr int NWAVES = 8, NTHREADS = 512;
constexpr int LDS_BYTES = 147456;
constexpr int RING_BYTES = 131072;

constexpr size_t MiB = 1u << 20;
constexpr size_t WS_WIN = 1 * MiB, WS_WOUT = 9 * MiB, WS_WUP = 12 * MiB, WS_WDN = 24 * MiB;
constexpr size_t WS_RS1 = 29 * MiB + 768 * 1024;
constexpr size_t WS_SSQ = 30 * MiB;
constexpr size_t WS_XN = 32 * MiB;
constexpr size_t WS_HG = 32 * MiB;
constexpr size_t WS_X1B = 32 * MiB;
constexpr size_t WS_PROJ = 96 * MiB;
constexpr size_t WS_MIX = 320 * MiB;
constexpr size_t WS_ATT = 384 * MiB;
constexpr size_t WS_G = 96 * MiB;
constexpr size_t WS_UL = 272 * MiB, WS_U01 = 275 * MiB, WS_V01 = 278 * MiB;
constexpr size_t WS_DL = 384 * MiB;
constexpr size_t WS_NEED = 512 * MiB;

__device__ __forceinline__ unsigned f2bf(float f) { unsigned u = __float_as_uint(f); return (u + 0x7fffu + ((u >> 16) & 1u)) >> 16; }
__device__ __forceinline__ unsigned pk2(float lo, float hi) { return f2bf(lo) | (f2bf(hi) << 16); }
__device__ __forceinline__ float bf2f(unsigned h) { return __uint_as_float(h << 16); }
#define WS_DPP_ADD(x, ctrl, rmask) x += __int_as_float(__builtin_amdgcn_update_dpp(0, __float_as_int(x), ctrl, rmask, 0xf, true))
__device__ __forceinline__ float wave_sum(float v) {
    WS_DPP_ADD(v, 0x111, 0xf); WS_DPP_ADD(v, 0x112, 0xf); WS_DPP_ADD(v, 0x114, 0xf); WS_DPP_ADD(v, 0x118, 0xf);
    WS_DPP_ADD(v, 0x142, 0xa); WS_DPP_ADD(v, 0x143, 0xc);
    return __int_as_float(__builtin_amdgcn_readlane(__float_as_int(v), 63));
}
template <int N> __device__ __forceinline__ void wave_sum_n(float (&x)[N]) {
#pragma unroll
    for (int i = 0; i < N; ++i) WS_DPP_ADD(x[i], 0x111, 0xf);
#pragma unroll
    for (int i = 0; i < N; ++i) WS_DPP_ADD(x[i], 0x112, 0xf);
#pragma unroll
    for (int i = 0; i < N; ++i) WS_DPP_ADD(x[i], 0x114, 0xf);
#pragma unroll
    for (int i = 0; i < N; ++i) WS_DPP_ADD(x[i], 0x118, 0xf);
#pragma unroll
    for (int i = 0; i < N; ++i) WS_DPP_ADD(x[i], 0x142, 0xa);
#pragma unroll
    for (int i = 0; i < N; ++i) WS_DPP_ADD(x[i], 0x143, 0xc);
#pragma unroll
    for (int i = 0; i < N; ++i) x[i] = __int_as_float(__builtin_amdgcn_readlane(__float_as_int(x[i]), 63));
}
__device__ __forceinline__ float sigmoidf_(float x) { return __builtin_amdgcn_rcpf(1.f + __builtin_amdgcn_exp2f(-1.4426950408889634f * x)); }

struct Args { const float* in[18]; float* out; unsigned char* ws; };

template <int MAPMODE> __device__ __forceinline__ void p0_transpose_item(const float* W, int K, int N, bf16_t* WT, const float* kscale, LAS float* scr, int item, int lane) {
    const int nblk = N / 32, kb = item / nblk, nb = item % nblk, k0 = 64 * kb, n0 = 32 * nb;
    const int orow0 = MAPMODE == 1 ? (((n0 % DFF) >> 7) * 256 + (n0 >= DFF ? 128 : 0) + ((n0 % DFF) & 127))
                    : (MAPMODE == 2 && n0 < 1024) ? ((n0 & ~255) + 128 * ((n0 >> 5) & 1) + 32 * ((n0 & 255) >> 6))
                    : (MAPMODE == 2 && n0 >= 1536 && n0 < 2560) ? ((6 + (((n0 - 1536) & 511) >> 7)) * 256 + (n0 >= 2048 ? 128 : 0) + (n0 & 127)) : n0;
#pragma unroll
    for (int i = 0; i < 8; ++i) { const int kk = 8 * i + (lane >> 3), cc = 4 * (lane & 7);
        f32x4 v = *(const f32x4*)(W + (size_t)(k0 + kk) * N + n0 + cc); if (kscale) v = v * kscale[k0 + kk];
        LAS float* d = scr + kk * 33 + cc; d[0] = v[0]; d[1] = v[1]; d[2] = v[2]; d[3] = v[3]; }
    asm volatile("s_waitcnt lgkmcnt(0)" ::: "memory");
    const int c = lane & 7;
#pragma unroll
    for (int j = 0; j < 4; ++j) { const int n = (lane >> 3) + 8 * j; const LAS float* s = scr + (8 * c) * 33 + n;
        u32x4 o; o.x = pk2(s[0 * 33], s[1 * 33]); o.y = pk2(s[2 * 33], s[3 * 33]); o.z = pk2(s[4 * 33], s[5 * 33]); o.w = pk2(s[6 * 33], s[7 * 33]);
        *(u32x4*)(WT + (size_t)(orow0 + n) * K + k0 + 8 * c) = o; }
    asm volatile("s_waitcnt lgkmcnt(0)" ::: "memory");
}


#define XB_TMO      128
#define XB_XCNT(j)  (256  + 64 * (j))
#define XB_XSUB(j)  (1280 + 64 * (j))
#define XB_XGEN(j)  (2304 + 64 * (j))
#define XB_TOP      3328
#define XB_TOPGEN   3392
#define XCD_BAR_WORDS 3456
#define XB_SPIN_CAP (1u << 18)
__device__ __forceinline__ unsigned xb_ld(unsigned* p)              { return __hip_atomic_load(p, __ATOMIC_RELAXED, __HIP_MEMORY_SCOPE_AGENT); }
__device__ __forceinline__ unsigned xb_add(unsigned* p, unsigned v) { return __hip_atomic_fetch_add(p, v, __ATOMIC_RELAXED, __HIP_MEMORY_SCOPE_AGENT); }
__device__ __forceinline__ unsigned xb_xcc_id() { return (unsigned)__builtin_amdgcn_s_getreg((3 << 11) | 20) & 0xFu; }
#define XB_SPIN(cond, bar) do { unsigned _sp = 0; while (cond) { __builtin_amdgcn_s_sleep(1); \
    if ((++_sp & 255u) == 0u) { if (xb_ld(&(bar)[XB_TMO])) break; if (_sp > XB_SPIN_CAP) { atomicAdd(&(bar)[XB_TMO], 1u); break; } } } } while (0)
struct XcdBarrier { unsigned* bar; unsigned x; volatile LAS unsigned* st; };
__device__ __forceinline__ XcdBarrier xcd_barrier_post(unsigned* bar, volatile LAS unsigned* st) {
    XcdBarrier b; b.bar = bar; b.x = xb_xcc_id(); b.st = st;
    if (threadIdx.x == 0) (void)xb_add(&bar[XB_XCNT(b.x)], 1u);
    return b;
}
__device__ __forceinline__ void xcd_barrier_complete(unsigned* bar, unsigned x, unsigned& nloc, unsigned& nx) {
    const unsigned G = gridDim.x * gridDim.y * gridDim.z;
    unsigned sum, cnt, mine, sp = 0u;
    for (;;) {
        sum = 0u; cnt = 0u; mine = 0u;
#pragma unroll
        for (unsigned j = 0; j < 16; ++j) { const unsigned c = xb_ld(&bar[XB_XCNT(j)]); sum += c; cnt += (c > 0u) ? 1u : 0u; mine = (j == x) ? c : mine; }
        if (sum == G) break;
        __builtin_amdgcn_s_sleep(1);
        if ((++sp & 255u) == 0u) { if (xb_ld(&bar[XB_TMO])) break; if (sp > XB_SPIN_CAP) { atomicAdd(&bar[XB_TMO], 1u); break; } }
    }
    nloc = mine > 0u ? mine : 1u; nx = cnt > 0u ? cnt : 1u;
}
__device__ __forceinline__ void xcd_barrier(const XcdBarrier& b) {
    asm volatile("s_waitcnt vmcnt(0)" ::: "memory");
    __syncthreads();
    if (threadIdx.x == 0) {
        unsigned* bar = b.bar;
        __builtin_amdgcn_s_waitcnt(0);
        unsigned nloc = b.st[0], nx = b.st[1];
        if (nloc == 0u) { xcd_barrier_complete(bar, b.x, nloc, nx); b.st[0] = nloc; b.st[1] = nx; }
        const unsigned old = xb_add(&bar[XB_XSUB(b.x)], 1u);
        const unsigned gen = old / nloc;
        if (old + 1u == (gen + 1u) * nloc) {
            __builtin_amdgcn_fence(__ATOMIC_RELEASE, "agent");
            asm volatile("s_waitcnt vmcnt(0)" ::: "memory");
            const unsigned og = xb_add(&bar[XB_TOP], 1u);
            const unsigned tg = og / nx;
            if (og + 1u == (tg + 1u) * nx) xb_add(&bar[XB_TOPGEN], 1u);
            else XB_SPIN(xb_ld(&bar[XB_TOPGEN]) == tg, bar);
            __builtin_amdgcn_fence(__ATOMIC_ACQUIRE, "agent");
            xb_add(&bar[XB_XGEN(b.x)], 1u);
            asm volatile("s_waitcnt vmcnt(0)" ::: "memory");
        } else {
            XB_SPIN(xb_ld(&bar[XB_XGEN(b.x)]) == gen, bar);
            __builtin_amdgcn_fence(__ATOMIC_ACQUIRE, "agent");
            asm volatile("s_waitcnt vmcnt(0)" ::: "memory");
        }
    }
    __syncthreads();
}
constexpr int CW_BAR = 4096;
constexpr int LDS_MISC = 147456 - 64;

typedef short bf16x8_t __attribute__((ext_vector_type(8)));
typedef short s16x4_t __attribute__((ext_vector_type(4)));
typedef float f32x16 __attribute__((ext_vector_type(16)));
typedef float f32x2_t __attribute__((ext_vector_type(2)));
typedef __bf16 bf16x2_t __attribute__((ext_vector_type(2)));
__device__ __forceinline__ unsigned cvtpk(float lo, float hi) { f32x2_t v = {lo, hi}; bf16x2_t b = __builtin_convertvector(v, bf16x2_t); return __builtin_bit_cast(unsigned, b); }
__device__ __forceinline__ bf16x8_t ld_row8(const LAS unsigned char* p) { return *(const LAS bf16x8_t*)p; }
__device__ __forceinline__ bf16x8_t ld_tr2(const LAS unsigned char* plo, const LAS unsigned char* phi) {
    const s16x4_t lo = __builtin_bit_cast(s16x4_t, __builtin_amdgcn_ds_read_tr16_b64_v4i16((LAS s16x4_t*)plo));
    const s16x4_t hi = __builtin_bit_cast(s16x4_t, __builtin_amdgcn_ds_read_tr16_b64_v4i16((LAS s16x4_t*)phi));
    return (bf16x8_t){lo[0], lo[1], lo[2], lo[3], hi[0], hi[1], hi[2], hi[3]};
}
__device__ __forceinline__ int crow(int r, int h) { return (r & 3) + 8 * (r >> 2) + 4 * h; }
constexpr float LOG2E = 1.4426950408889634f;
constexpr float QSCALE = 0.125f * LOG2E;

namespace fa {
constexpr int SLOT = 32768, NSLOT = 4, KB_ = 0, VB_ = 16384;
constexpr int RB0 = 2 * SLOT, RSRB = 272, RTB = 128 * RSRB;
constexpr int OFF_WL = RB0 + 2 * RTB;
constexpr int OFF_Q = OFF_WL + 1024;
static_assert(OFF_WL >= NSLOT * SLOT && OFF_Q + 16 + 512 <= LDS_MISC, "attention LDS map");
#define FA_SB() __builtin_amdgcn_sched_barrier(0)

__device__ __forceinline__ int attn_run(LAS unsigned char* lds, const bf16_t* __restrict__ PROJ, bf16_t* __restrict__ MIX, const float* __restrict__ sublnw, unsigned* ctl,
                                        float lam, int tid, int lane, int wave) {
    const int r32 = lane & 31, hi = lane >> 5, rb = wave & 3, c = wave >> 2;
    LAS int* qslot = (LAS int*)(lds + OFF_Q);
    LAS float* swl = (LAS float*)(lds + OFF_Q + 16);
    if (tid < 128) swl[tid] = sublnw[tid];
    int kof[4], vof[4];
    const int g4 = lane >> 4, i16 = lane & 15, q4 = i16 >> 2, p4 = i16 & 3;
#pragma unroll
    for (int d0 = 0; d0 < 4; ++d0) kof[d0] = KB_ + r32 * 256 + (((c * 8 + 2 * d0 + hi) ^ (r32 & 15)) << 4);
#pragma unroll
    for (int eb = 0; eb < 4; ++eb) vof[eb] = VB_ + (4 * hi + q4) * 256 + ((4 * (eb ^ q4) + 2 * (g4 & 1) + (p4 >> 1)) << 4) + 8 * (p4 & 1);
    size_t goff[4];
#pragma unroll
    for (int i = 0; i < 2; ++i) {
        const int row = 8 * wave + 4 * i + (lane >> 4), pc = lane & 15;
        goff[i]     = (size_t)row * NCOLS + OFF_DK + ((pc ^ (row & 15)) << 3);
        goff[2 + i] = (size_t)row * NCOLS + OFF_DV + ((pc ^ ((row & 3) << 2)) << 3);
    }
#define FA_DMA(gbase, t, slot) do { const bf16_t* g_ = (gbase) + (size_t)(t) * 64 * NCOLS; LAS unsigned char* d_ = lds + (slot) * SLOT + wave * 2048; \
        __builtin_amdgcn_global_load_lds((const unsigned*)(g_ + goff[0]), (LAS unsigned*)(d_ + KB_), 16, 0, 0); \
        __builtin_amdgcn_global_load_lds((const unsigned*)(g_ + goff[1]), (LAS unsigned*)(d_ + KB_ + 1024), 16, 0, 0); \
        __builtin_amdgcn_global_load_lds((const unsigned*)(g_ + goff[2]), (LAS unsigned*)(d_ + VB_), 16, 0, 0); \
        __builtin_amdgcn_global_load_lds((const unsigned*)(g_ + goff[3]), (LAS unsigned*)(d_ + VB_ + 1024), 16, 0, 0); } while (0)
#define FA_DMA1(gbase, t, slot, i) __builtin_amdgcn_global_load_lds((const unsigned*)((gbase) + (size_t)(t) * 64 * NCOLS + goff[i]), \
        (LAS unsigned*)(lds + (slot) * SLOT + wave * 2048 + ((i) >> 1) * VB_ + ((i) & 1) * 1024), 16, 0, 0)
#define FA_PREFETCH(uu, qdst) do { const int b_ = ((uu) & 63) >> 2, h_ = (uu) & 3, qb_ = 15 - ((uu) >> 6); \
        const bf16_t* qp_ = PROJ + ((size_t)b_ * S + qb_ * 128 + rb * 32 + r32) * NCOLS + OFF_DQ + h_ * 128 + c * 64 + hi * 8; \
        _Pragma("unroll") for (int d0 = 0; d0 < 4; ++d0) qdst[d0] = *(const bf16x8_t*)(qp_ + d0 * 16); \
        const bf16_t* gb_ = PROJ + (size_t)b_ * S * NCOLS + h_ * 128; FA_DMA(gb_, 0, 0); FA_DMA(gb_, 1, 1); } while (0)
    if (tid == 0) *qslot = (int)__hip_atomic_fetch_add(ctl, 1u, __ATOMIC_RELAXED, __HIP_MEMORY_SCOPE_AGENT);
    __syncthreads();
    int u = __builtin_amdgcn_readfirstlane(*qslot);
    __syncthreads();
    if (u >= 1024) return u;
    bf16x8_t qr[4], qn[4];
    FA_PREFETCH(u, qr);
    for (;;) {
        if (tid == 0) *qslot = (int)__hip_atomic_fetch_add(ctl, 1u, __ATOMIC_RELAXED, __HIP_MEMORY_SCOPE_AGENT);
        const int b = (u & 63) >> 2, h = u & 3, qb = 15 - (u >> 6);
        const size_t rowbase = (size_t)b * S;
        const bf16_t* gbase = PROJ + rowbase * NCOLS + h * 128;
        const int NT = 2 * qb + 2, cw = 2 * qb + (rb >> 1);
        f32x16 o[4];
#pragma unroll
        for (int e = 0; e < 4; ++e)
#pragma unroll
            for (int r = 0; r < 16; ++r) o[e][r] = 0.f;
        float lsum = 0.f;
        f32x16 C[2];
        const f32x16 fzero = {0.f, 0.f, 0.f, 0.f, 0.f, 0.f, 0.f, 0.f, 0.f, 0.f, 0.f, 0.f, 0.f, 0.f, 0.f, 0.f};
        unsigned pw[16], pwn[16];
#pragma unroll
        for (int i = 0; i < 16; ++i) { pw[i] = 0u; pwn[i] = 0u; }
#define FA_VFRAG(slB, j) ld_tr2((slB) + vof[(j) & 3] + (((j) >> 2) * 16) * 256, (slB) + vof[(j) & 3] + (((j) >> 2) * 16 + 8) * 256)
#define FA_PW(ks) __builtin_bit_cast(bf16x8_t, (u32x4){pw[4 * (ks)], pw[4 * (ks) + 1], pw[4 * (ks) + 2], pw[4 * (ks) + 3]})
#define FA_STEP(DO_A, DO_B, slA, slB, masked, dma_on, dma_t, dma_slot) do { \
            bf16x8_t vf[16]; bf16x8_t ka[4], kb2[4]; \
            if (DO_A) { ka[0] = ld_row8((slA) + kof[0]); kb2[0] = ld_row8((slA) + kof[0] + 8192); \
                        ka[1] = ld_row8((slA) + kof[1]); kb2[1] = ld_row8((slA) + kof[1] + 8192); \
                if (masked) { _Pragma("unroll") for (int r = 0; r < 16; ++r) { C[0][r] = -1.0e30f; C[1][r] = -1.0e30f; } \
                    C[0] = __builtin_amdgcn_mfma_f32_32x32x16_bf16(ka[0], qr[0], C[0], 0, 0, 0); FA_SB(); C[1] = __builtin_amdgcn_mfma_f32_32x32x16_bf16(kb2[0], qr[0], C[1], 0, 0, 0); FA_SB(); } \
                else { C[0] = __builtin_amdgcn_mfma_f32_32x32x16_bf16(ka[0], qr[0], fzero, 0, 0, 0); FA_SB(); C[1] = __builtin_amdgcn_mfma_f32_32x32x16_bf16(kb2[0], qr[0], fzero, 0, 0, 0); FA_SB(); } } \
            _Pragma("unroll") for (int d0 = 1; d0 < 4; ++d0) { \
                if (DO_A && d0 < 3) { ka[d0 + 1] = ld_row8((slA) + kof[d0 + 1]); kb2[d0 + 1] = ld_row8((slA) + kof[d0 + 1] + 8192); } \
                if (DO_A) C[0] = __builtin_amdgcn_mfma_f32_32x32x16_bf16(ka[d0], qr[d0], C[0], 0, 0, 0); \
                if (DO_B && 2 * d0 >= 4) vf[2 * d0 - 4] = FA_VFRAG(slB, 2 * d0 - 4); \
                FA_SB(); \
                if (DO_A) C[1] = __builtin_amdgcn_mfma_f32_32x32x16_bf16(kb2[d0], qr[d0], C[1], 0, 0, 0); \
                if (DO_B && 2 * d0 + 1 >= 4) vf[2 * d0 - 3] = FA_VFRAG(slB, 2 * d0 - 3); \
                if (DO_A) { if (dma_on) { FA_DMA1(gbase, dma_t, dma_slot, d0); if (d0 == 1) FA_DMA1(gbase, dma_t, dma_slot, 0); } } \
                FA_SB(); } \
            if (DO_B && !(DO_A)) { _Pragma("unroll") for (int j = 0; j < 4; ++j) vf[j] = FA_VFRAG(slB, j); } \
            _Pragma("unroll") for (int j = 0; j < 16; ++j) { \
                if (DO_B) o[j & 3] = __builtin_amdgcn_mfma_f32_32x32x16_bf16(FA_PW(j >> 2), vf[j], o[j & 3], 0, 0, 0); \
                if (DO_B && j + 4 < 16) vf[j + 4] = FA_VFRAG(slB, j + 4); \
                if (DO_A) { C[(2 * j) >> 4][(2 * j) & 15] = __builtin_amdgcn_exp2f(C[(2 * j) >> 4][(2 * j) & 15]); C[(2 * j + 1) >> 4][(2 * j + 1) & 15] = __builtin_amdgcn_exp2f(C[(2 * j + 1) >> 4][(2 * j + 1) & 15]); \
                    if (j >= 1) { const float a_ = C[(2 * j - 2) >> 4][(2 * j - 2) & 15], b_ = C[(2 * j - 1) >> 4][(2 * j - 1) & 15]; pwn[j - 1] = cvtpk(a_, b_); lsum += a_; lsum += b_; } } \
                FA_SB(); } \
            if (DO_A) { const float a_ = C[1][14], b_ = C[1][15]; pwn[15] = cvtpk(a_, b_); lsum += a_; lsum += b_; } \
            _Pragma("unroll") for (int i = 0; i < 16; ++i) pw[i] = pwn[i]; \
            FA_SB(); } while (0)
        asm volatile("s_waitcnt vmcnt(4)" ::: "memory");
        asm volatile("s_waitcnt lgkmcnt(0)" ::: "memory"); __builtin_amdgcn_s_barrier(); asm volatile("" ::: "memory");
        FA_STEP(true, false, lds, lds, false, 2 < NT, 2, 2);
        int slot = 1;
        for (int t = 1; t < NT; ++t) {
            if (t + 1 < NT) asm volatile("s_waitcnt vmcnt(4)" ::: "memory"); else asm volatile("s_waitcnt vmcnt(0)" ::: "memory");
            asm volatile("s_waitcnt lgkmcnt(0)" ::: "memory"); __builtin_amdgcn_s_barrier(); asm volatile("" ::: "memory");
            const LAS unsigned char* slA = lds + slot * SLOT; const LAS unsigned char* slB = lds + ((slot + 3) & 3) * SLOT;
            FA_STEP(true, true, slA, slB, t > cw, t + 2 < NT, t + 2, (slot + 2) & 3);
            slot = (slot + 1) & 3;
        }
        { const LAS unsigned char* slB = lds + ((slot + 3) & 3) * SLOT; FA_STEP(false, true, slB, slB, false, false, 0, 0); }
        asm volatile("s_waitcnt lgkmcnt(0)" ::: "memory"); __builtin_amdgcn_s_barrier(); asm volatile("" ::: "memory");
        const int un = __builtin_amdgcn_readfirstlane(*qslot);
        if (un < 1024) FA_PREFETCH(un, qn);
        lsum += __shfl_xor(lsum, 32);
        LAS float* wl = (LAS float*)(lds + OFF_WL) + wave * 32;
        if (hi == 0) wl[r32] = lsum;
        asm volatile("s_waitcnt lgkmcnt(0)" ::: "memory");
        {
            LAS unsigned char* R = lds + RB0 + c * RTB + (rb * 32) * RSRB + r32 * 2;
#pragma unroll
            for (int r = 0; r < 16; ++r) {
                const float rl = (c ? lam : 1.f) * __builtin_amdgcn_rcpf(wl[crow(r, hi)]);
#pragma unroll
                for (int eb = 0; eb < 4; ++eb) *(LAS unsigned short*)(R + crow(r, hi) * RSRB + eb * 64) = (unsigned short)cvtpk(o[eb][r] * rl, 0.f);
            }
        }
        asm volatile("s_waitcnt lgkmcnt(0)" ::: "memory"); __builtin_amdgcn_s_barrier(); asm volatile("" ::: "memory");
        for (int it = 0; it < 2; ++it) {
            const int row = wave * 16 + it * 8 + (lane >> 3), sg = lane & 7;
            const LAS unsigned char* rp = lds + RB0 + row * RSRB + sg * 32;
            const u32x4 a0 = *(const LAS u32x4*)rp, a1 = *(const LAS u32x4*)(rp + 16), b0 = *(const LAS u32x4*)(rp + RTB), b1 = *(const LAS u32x4*)(rp + RTB + 16);
            const f32x4 w0 = *(const LAS f32x4*)(swl + sg * 16), w1 = *(const LAS f32x4*)(swl + sg * 16 + 4), w2 = *(const LAS f32x4*)(swl + sg * 16 + 8), w3 = *(const LAS f32x4*)(swl + sg * 16 + 12);
            float dv[16];
#pragma unroll
            for (int i = 0; i < 4; ++i) {
                dv[2 * i]     = __uint_as_float(a0[i] << 16) - __uint_as_float(b0[i] << 16);         dv[2 * i + 1] = __uint_as_float(a0[i] & 0xffff0000u) - __uint_as_float(b0[i] & 0xffff0000u);
                dv[8 + 2 * i] = __uint_as_float(a1[i] << 16) - __uint_as_float(b1[i] << 16);     dv[8 + 2 * i + 1] = __uint_as_float(a1[i] & 0xffff0000u) - __uint_as_float(b1[i] & 0xffff0000u);
            }
            float ss = 0.f;
#pragma unroll
            for (int i = 0; i < 16; i += 4) ss += (dv[i] * dv[i] + dv[i + 1] * dv[i + 1]) + (dv[i + 2] * dv[i + 2] + dv[i + 3] * dv[i + 3]);
            ss += __int_as_float(__builtin_amdgcn_update_dpp(0, __float_as_int(ss), 0xB1, 0xf, 0xf, true));
            ss += __int_as_float(__builtin_amdgcn_update_dpp(0, __float_as_int(ss), 0x4E, 0xf, 0xf, true));
            ss += __int_as_float(__builtin_amdgcn_update_dpp(0, __float_as_int(ss), 0x141, 0xf, 0xf, true));
            const float rr = rsqrtf(ss * (1.f / 128.f) + EPS) * (1.f - LAM_INIT);
            u32x4 o0, o1;
#pragma unroll
            for (int i = 0; i < 2; ++i) {
                o0[i]     = cvtpk(dv[2 * i] * rr * w0[2 * i], dv[2 * i + 1] * rr * w0[2 * i + 1]);
                o0[2 + i] = cvtpk(dv[4 + 2 * i] * rr * w1[2 * i], dv[4 + 2 * i + 1] * rr * w1[2 * i + 1]);
                o1[i]     = cvtpk(dv[8 + 2 * i] * rr * w2[2 * i], dv[8 + 2 * i + 1] * rr * w2[2 * i + 1]);
                o1[2 + i] = cvtpk(dv[12 + 2 * i] * rr * w3[2 * i], dv[12 + 2 * i + 1] * rr * w3[2 * i + 1]);
            }
            bf16_t* op = MIX + (rowbase + qb * 128 + row) * D + h * 128 + sg * 16;
            *(u32x4*)op = o0; *(u32x4*)(op + 8) = o1;
        }
        asm volatile("s_waitcnt vmcnt(0)" ::: "memory");
        asm volatile("s_waitcnt lgkmcnt(0)" ::: "memory"); __builtin_amdgcn_s_barrier(); asm volatile("" ::: "memory");
        if (un >= 1024) return un;
        u = un;
#pragma unroll
        for (int d0 = 0; d0 < 4; ++d0) qr[d0] = qn[d0];
    }
#undef FA_STEP
#undef FA_PW
#undef FA_VFRAG
#undef FA_DMA
#undef FA_DMA1
#undef FA_PREFETCH
}
#undef FA_SB
}


namespace hg {
constexpr int RSQ = 272, RSKR = 272, RSKC = 320, RSV = 320, RSA = 144, RSS = 272, RSR = 132;
constexpr int OFF_QT = 0;
constexpr int OFF_KR = OFF_QT + 64 * RSQ;
constexpr int OFF_KC = OFF_KR + 64 * RSKR;
constexpr int OFF_VT = OFF_KC + 64 * RSKC;
constexpr int OFF_AM = OFF_VT + 64 * RSV;
constexpr int OFF_ST = OFF_AM + 64 * RSA;
constexpr int OFF_BL = OFF_ST + 128 * RSS;
constexpr int OFF_GT = OFF_BL + 512;
constexpr int OFF_R = OFF_KR;
static_assert(OFF_GT + 64 * 256 <= LDS_MISC && 64 * RSR * 4 <= 64 * RSKR + 64 * RSKC, "hgrn LDS map");


#define HG_DPP_ADD(x, ctrl) x += __int_as_float(__builtin_amdgcn_update_dpp(0, __float_as_int(x), ctrl, 0xf, 0xf, true))
__device__ __forceinline__ void hgrn_pre_wave(bf16_t* PROJ, const float* __restrict__ lbl, float* __restrict__ DL, int b0, int h, int ch, int c4, int lane) {
    const int tr = lane & 15, cc = lane >> 4, col = h * 128 + 32 * c4 + 8 * cc;
    float lbv[8];
#pragma unroll
    for (int j = 0; j < 8; ++j) { const float l0 = lbl[col + j], l1 = lbl[512 + col + j]; lbv[j] = __builtin_amdgcn_rcpf(1.f + __builtin_amdgcn_exp2f((l1 - l0) * 1.4426950408889634f)); }
    bf16_t* gq = PROJ + ((size_t)b0 * S + ch * 64 + 4 * tr) * NCOLS + OFF_HQ + col;
    bf16_t* gf = PROJ + ((size_t)b0 * S + ch * 64 + 4 * tr) * NCOLS + OFF_HF + col;
    u32x4 nq[4], nf[4];
#pragma unroll
    for (int m = 0; m < 4; ++m) { nq[m] = *(const u32x4*)(gq + m * NCOLS); nf[m] = *(const u32x4*)(gf + m * NCOLS); }
    for (int k = 0; k < NB / 4; ++k) {
        u32x4 wq[4], wf[4];
#pragma unroll
        for (int m = 0; m < 4; ++m) { wq[m] = nq[m]; wf[m] = nf[m]; }
        bf16_t* cq = gq; bf16_t* cf = gf;
        if (k + 1 < NB / 4) { gq += (size_t)4 * S * NCOLS; gf += (size_t)4 * S * NCOLS;
#pragma unroll
            for (int m = 0; m < 4; ++m) { nq[m] = *(const u32x4*)(gq + m * NCOLS); nf[m] = *(const u32x4*)(gf + m * NCOLS); } }
        float bc[4][8], omf[4][8];
#pragma unroll
        for (int m = 0; m < 4; ++m)
#pragma unroll
            for (int j = 0; j < 8; ++j) {
                const unsigned w = wf[m][j >> 1];
                const float z = bf2f((j & 1) ? (w >> 16) : (w & 0xffffu));
                const float f = lbv[j] + (1.f - lbv[j]) * sigmoidf_(z);
                omf[m][j] = 1.f - f; bc[m][j] = __builtin_amdgcn_logf(f) + (m ? bc[m - 1][j] : 0.f);
            }
#pragma unroll
        for (int j = 0; j < 8; ++j) {
            float tot = bc[3][j];
            HG_DPP_ADD(tot, 0x111); HG_DPP_ADD(tot, 0x112); HG_DPP_ADD(tot, 0x114); HG_DPP_ADD(tot, 0x118);
            const float carry = tot - bc[3][j];
#pragma unroll
            for (int m = 0; m < 4; ++m) bc[m][j] += carry;
        }
#pragma unroll
        for (int m = 0; m < 4; ++m) {
            unsigned oq[4], ok[4];
#pragma unroll
            for (int i = 0; i < 4; ++i) {
                const float q0 = bf2f(wq[m][i] & 0xffffu), q1 = bf2f(wq[m][i] >> 16);
                const float e0 = __builtin_amdgcn_exp2f(bc[m][2 * i]), e1 = __builtin_amdgcn_exp2f(bc[m][2 * i + 1]), n0 = __builtin_amdgcn_exp2f(-bc[m][2 * i]), n1 = __builtin_amdgcn_exp2f(-bc[m][2 * i + 1]);
                oq[i] = cvtpk(q0 * e0, q1 * e1); ok[i] = cvtpk(omf[m][2 * i] * n0, omf[m][2 * i + 1] * n1);
            }
            *(u32x4*)(cq + m * NCOLS) = (u32x4){oq[0], oq[1], oq[2], oq[3]};
            *(u32x4*)(cf + m * NCOLS) = (u32x4){ok[0], ok[1], ok[2], ok[3]};
        }
        if (tr == 15) {
            float* dp = DL + (size_t)(((b0 + 4 * k) * 4 + h) * 32 + ch) * 128 + 32 * c4 + 8 * cc;
            *(f32x4*)dp = (f32x4){__builtin_amdgcn_exp2f(bc[3][0]), __builtin_amdgcn_exp2f(bc[3][1]), __builtin_amdgcn_exp2f(bc[3][2]), __builtin_amdgcn_exp2f(bc[3][3])};
            *(f32x4*)(dp + 4) = (f32x4){__builtin_amdgcn_exp2f(bc[3][4]), __builtin_amdgcn_exp2f(bc[3][5]), __builtin_amdgcn_exp2f(bc[3][6]), __builtin_amdgcn_exp2f(bc[3][7])};
        }
    }
}
#undef HG_DPP_ADD

__device__ __forceinline__ void hgrn_unit(LAS unsigned char* lds, const bf16_t* __restrict__ PROJ, bf16_t* __restrict__ MIX, const float* __restrict__ DL, const float* __restrict__ hnw,
                                          int b, int h, int tid, int lane, int wave) {
    const int r32 = lane & 31, hi = lane >> 5, g4 = lane >> 4, i16 = lane & 15;
    const size_t rowbase = (size_t)b * S;
    f32x16 sreg[2];
#pragma unroll
    for (int j = 0; j < 2; ++j)
#pragma unroll
        for (int r = 0; r < 16; ++r) sreg[j][r] = 0.f;
    for (int i = tid; i < 128 * RSS / 16; i += NTHREADS) *(LAS u32x4*)(lds + OFF_ST + i * 16) = (u32x4){0u, 0u, 0u, 0u};
    const int vb = wave & 3, kb0 = 2 * (wave >> 2), tb = wave >> 2;
    const int trb = (8 * hi + (i16 >> 2)) * 320 + (16 * (g4 & 1) + 4 * (i16 & 3)) * 2;
    const int rrb = r32 * 272 + hi * 16;
    const int half = wave >> 2, st = tid & 255, srow = st >> 4, sch = st & 15;
    const bf16_t* gq = PROJ + (rowbase + srow) * NCOLS + OFF_HQ + h * 128 + sch * 8;
    const bf16_t* gf = PROJ + (rowbase + srow) * NCOLS + OFF_HF + h * 128 + sch * 8;
    const bf16_t* gi = PROJ + (rowbase + srow) * NCOLS + OFF_HI + h * 128 + sch * 8;
    const bf16_t* gg = PROJ + (rowbase + srow) * NCOLS + OFF_HG + h * 128 + sch * 8;
    const float* gd = DL + (size_t)((b * 4 + h) * 32) * 128 + (st & 31) * 4;
    u32x4 nq[4], nf[4], nv[4], ng[4]; f32x4 nd = (f32x4){0.f, 0.f, 0.f, 0.f};
#define HG_LD16(dst, ptr) asm volatile("global_load_dwordx4 %0, %1, off" : "=v"(dst) : "v"(ptr) : "memory")
#define HG_LOAD(chn) do { const size_t o_ = (size_t)(chn) * 64 * NCOLS; \
        _Pragma("unroll") for (int i = 0; i < 4; ++i) { HG_LD16(nq[i], gq + o_ + i * 16 * NCOLS); HG_LD16(nf[i], gf + o_ + i * 16 * NCOLS); HG_LD16(nv[i], gi + o_ + i * 16 * NCOLS); HG_LD16(ng[i], gg + o_ + i * 16 * NCOLS); } \
        HG_LD16(nd, gd + (chn) * 128); } while (0)
#define HG_TIES "+v"(nq[0]), "+v"(nq[1]), "+v"(nq[2]), "+v"(nq[3]), "+v"(nf[0]), "+v"(nf[1]), "+v"(nf[2]), "+v"(nf[3]), "+v"(nv[0]), "+v"(nv[1]), "+v"(nv[2]), "+v"(nv[3]), \
                "+v"(ng[0]), "+v"(ng[1]), "+v"(ng[2]), "+v"(ng[3]), "+v"(nd)
    HG_LOAD(half);
    {
        const u32x4 zero_ = (u32x4){0u, 0u, 0u, 0u};
        bf16_t* op = MIX + (rowbase + wave * 8 + (lane >> 3)) * D + 512 + h * 128 + (lane & 7) * 16;
        asm volatile("global_store_dwordx4 %0, %1, off\n\ts_nop 1" :: "v"(op), "v"(zero_) : "memory");
        asm volatile("global_store_dwordx4 %0, %1, off\n\ts_nop 1" :: "v"(op + 8), "v"(zero_) : "memory");
        if (half == 0) {
            asm volatile("global_store_dwordx4 %0, %1, off\n\ts_nop 1" :: "v"(op), "v"(zero_) : "memory");
            asm volatile("global_store_dwordx4 %0, %1, off\n\ts_nop 1" :: "v"(op + 8), "v"(zero_) : "memory");
        }
    }
    for (int ch = 0; ch < S / 64; ++ch) {
        if (half == (ch & 1)) {
            asm volatile("s_waitcnt vmcnt(4)" : HG_TIES :: "memory");
#pragma unroll
            for (int i = 0; i < 4; ++i) {
                *(LAS u32x4*)(lds + OFF_QT + (srow + 16 * i) * RSQ + sch * 16) = nq[i];
                *(LAS u32x4*)(lds + OFF_KR + (srow + 16 * i) * RSKR + sch * 16) = nf[i];
                *(LAS u32x4*)(lds + OFF_KC + (srow + 16 * i) * RSKC + sch * 16) = nf[i];
                *(LAS u32x4*)(lds + OFF_VT + (srow + 16 * i) * RSV + sch * 16) = nv[i];
                *(LAS u32x4*)(lds + OFF_GT + (srow + 16 * i) * 256 + sch * 16) = ng[i];
            }
            if (st < 32) *(LAS f32x4*)(lds + OFF_BL + st * 16) = nd;
            if (ch + 2 < S / 64) HG_LOAD(ch + 2);
        }
        __syncthreads();
        {
            const LAS unsigned char* ka = lds + OFF_KC + trb + kb0 * 64;
            const LAS unsigned char* va = lds + OFF_VT + trb + vb * 64;
            bf16x8_t wb[4], wa0[4], wa1[4];
#define HG_WLD(i) do { wb[i] = ld_tr2(va + (i) * 16 * 320, va + (i) * 16 * 320 + 4 * 320); wa0[i] = ld_tr2(ka + (i) * 16 * 320, ka + (i) * 16 * 320 + 4 * 320); \
                       wa1[i] = ld_tr2(ka + 64 + (i) * 16 * 320, ka + 64 + (i) * 16 * 320 + 4 * 320); } while (0)
#define HG_WMM(i) do { sreg[0] = __builtin_amdgcn_mfma_f32_32x32x16_bf16(wa0[i], wb[i], sreg[0], 0, 0, 0); sreg[1] = __builtin_amdgcn_mfma_f32_32x32x16_bf16(wa1[i], wb[i], sreg[1], 0, 0, 0); } while (0)
            HG_WLD(0); HG_WLD(1);
            if (wave < 3) {
                const int sb = wave >> 1, tbb = (wave + 1) >> 1;
                const LAS unsigned char* kr = lds + OFF_KR + rrb + sb * 32 * RSKR;
                const LAS unsigned char* qr_ = lds + OFF_QT + rrb + tbb * 32 * RSQ;
                bf16x8_t xk[8], xq[8];
                __builtin_amdgcn_sched_barrier(0);
                HG_WMM(0); HG_WLD(2);
#pragma unroll
                for (int k = 0; k < 2; ++k) { xk[k] = ld_row8(kr + k * 32); xq[k] = ld_row8(qr_ + k * 32); }
                __builtin_amdgcn_sched_barrier(0);
                HG_WMM(1); HG_WLD(3);
#pragma unroll
                for (int k = 2; k < 4; ++k) { xk[k] = ld_row8(kr + k * 32); xq[k] = ld_row8(qr_ + k * 32); }
                __builtin_amdgcn_sched_barrier(0);
                HG_WMM(2);
#pragma unroll
                for (int k = 4; k < 6; ++k) { xk[k] = ld_row8(kr + k * 32); xq[k] = ld_row8(qr_ + k * 32); }
                __builtin_amdgcn_sched_barrier(0);
                HG_WMM(3);
#pragma unroll
                for (int k = 6; k < 8; ++k) { xk[k] = ld_row8(kr + k * 32); xq[k] = ld_row8(qr_ + k * 32); }
                __builtin_amdgcn_sched_barrier(0);
                f32x16 acc;
#pragma unroll
                for (int r = 0; r < 16; ++r) acc[r] = 0.f;
#pragma unroll
                for (int k = 0; k < 8; ++k) acc = __builtin_amdgcn_mfma_f32_32x32x16_bf16(xk[k], xq[k], acc, 0, 0, 0);
                if (sb == tbb) {
#pragma unroll
                    for (int r = 0; r < 16; ++r) if (crow(r, hi) > r32) acc[r] = 0.f;
                }
                LAS unsigned char* am = lds + OFF_AM + (32 * tbb + r32) * RSA + (32 * sb + 4 * hi) * 2;
#pragma unroll
                for (int g = 0; g < 4; ++g) *(LAS u32x2*)(am + 16 * g) = (u32x2){cvtpk(acc[4 * g], acc[4 * g + 1]), cvtpk(acc[4 * g + 2], acc[4 * g + 3])};
            } else {
                __builtin_amdgcn_sched_barrier(0);
                HG_WMM(0); HG_WLD(2);
                __builtin_amdgcn_sched_barrier(0);
                HG_WMM(1); HG_WLD(3);
                __builtin_amdgcn_sched_barrier(0);
                HG_WMM(2); HG_WMM(3);
            }
#undef HG_WLD
#undef HG_WMM
            const LAS float* bl = (const LAS float*)(lds + OFF_BL);
#pragma unroll
            for (int j = 0; j < 2; ++j)
#pragma unroll
                for (int g = 0; g < 4; ++g) {
                    const f32x4 bv = *(const LAS f32x4*)(bl + 32 * (kb0 + j) + 8 * g + 4 * hi);
                    sreg[j][4 * g] *= bv[0]; sreg[j][4 * g + 1] *= bv[1]; sreg[j][4 * g + 2] *= bv[2]; sreg[j][4 * g + 3] *= bv[3];
                }
        }
        __syncthreads();
        {
            f32x16 acc;
#pragma unroll
            for (int r = 0; r < 16; ++r) acc[r] = 0.f;
            const LAS unsigned char* amr = lds + OFF_AM + (32 * tb + r32) * RSA + hi * 16;
            const LAS unsigned char* va = lds + OFF_VT + trb + vb * 64;
            const LAS unsigned char* qr_ = lds + OFF_QT + rrb + tb * 32 * RSQ;
            const LAS unsigned char* sr_ = lds + OFF_ST + rrb + vb * 32 * RSS;
            bf16x8_t ya[4], yv[4], yq[8], ys[8];
#pragma unroll
            for (int i = 0; i < 2; ++i) { ya[i] = ld_row8(amr + i * 32); yv[i] = ld_tr2(va + i * 16 * 320, va + i * 16 * 320 + 4 * 320); }
            if (tb) {
#pragma unroll
                for (int i = 2; i < 4; ++i) { ya[i] = ld_row8(amr + i * 32); yv[i] = ld_tr2(va + i * 16 * 320, va + i * 16 * 320 + 4 * 320); }
            }
#pragma unroll
            for (int k = 0; k < 4; ++k) { yq[k] = ld_row8(qr_ + k * 32); ys[k] = ld_row8(sr_ + k * 32); }
            __builtin_amdgcn_sched_barrier(0);
#pragma unroll
            for (int i = 0; i < 2; ++i) acc = __builtin_amdgcn_mfma_f32_32x32x16_bf16(ya[i], yv[i], acc, 0, 0, 0);
            if (tb) {
#pragma unroll
                for (int i = 2; i < 4; ++i) acc = __builtin_amdgcn_mfma_f32_32x32x16_bf16(ya[i], yv[i], acc, 0, 0, 0);
            }
#pragma unroll
            for (int k = 4; k < 8; ++k) { yq[k] = ld_row8(qr_ + k * 32); ys[k] = ld_row8(sr_ + k * 32); }
            __builtin_amdgcn_sched_barrier(0);
#pragma unroll
            for (int k = 0; k < 8; ++k) acc = __builtin_amdgcn_mfma_f32_32x32x16_bf16(yq[k], ys[k], acc, 0, 0, 0);
            LAS float* R = (LAS float*)(lds + OFF_R) + vb * 32 + r32;
#pragma unroll
            for (int r = 0; r < 16; ++r) R[(32 * tb + crow(r, hi)) * RSR] = acc[r];
        }
        __syncthreads();
        {
#pragma unroll
            for (int j = 0; j < 2; ++j) {
                LAS unsigned char* sp = lds + OFF_ST + (32 * vb + r32) * RSS + (32 * (kb0 + j) + 4 * hi) * 2;
#pragma unroll
                for (int g = 0; g < 4; ++g) *(LAS u32x2*)(sp + 16 * g) = (u32x2){cvtpk(sreg[j][4 * g], sreg[j][4 * g + 1]), cvtpk(sreg[j][4 * g + 2], sreg[j][4 * g + 3])};
            }
            {
                const int rw = lane >> 3, sg = lane & 7, t = wave * 8 + rw;
                const LAS float* rp = (const LAS float*)(lds + OFF_R) + t * RSR + sg * 16;
                const f32x4 r0 = *(const LAS f32x4*)rp, r1 = *(const LAS f32x4*)(rp + 4), r2 = *(const LAS f32x4*)(rp + 8), r3 = *(const LAS f32x4*)(rp + 12);
                const u32x4 g0 = *(const LAS u32x4*)(lds + OFF_GT + t * 256 + sg * 32), g1 = *(const LAS u32x4*)(lds + OFF_GT + t * 256 + sg * 32 + 16);
                float ss = 0.f;
#pragma unroll
                for (int i = 0; i < 4; ++i) ss += (r0[i] * r0[i] + r1[i] * r1[i]) + (r2[i] * r2[i] + r3[i] * r3[i]);
                ss += __int_as_float(__builtin_amdgcn_update_dpp(0, __float_as_int(ss), 0xB1, 0xf, 0xf, true));
                ss += __int_as_float(__builtin_amdgcn_update_dpp(0, __float_as_int(ss), 0x4E, 0xf, 0xf, true));
                ss += __int_as_float(__builtin_amdgcn_update_dpp(0, __float_as_int(ss), 0x141, 0xf, 0xf, true));
                const float rr = rsqrtf(ss * (1.f / 128.f) + EPS);
#define HG_PK(rv, gw, j) cvtpk(rv[2 * (j)] * rr * __uint_as_float(gw << 16), rv[2 * (j) + 1] * rr * __uint_as_float(gw & 0xffff0000u))
                const u32x4 o0 = (u32x4){HG_PK(r0, g0[0], 0), HG_PK(r0, g0[1], 1), HG_PK(r1, g0[2], 0), HG_PK(r1, g0[3], 1)};
                const u32x4 o1 = (u32x4){HG_PK(r2, g1[0], 0), HG_PK(r2, g1[1], 1), HG_PK(r3, g1[2], 0), HG_PK(r3, g1[3], 1)};
#undef HG_PK
                bf16_t* op = MIX + (rowbase + ch * 64 + t) * D + 512 + h * 128 + sg * 16;
                asm volatile("global_store_dwordx4 %0, %1, off\n\ts_nop 1" :: "v"(op), "v"(o0) : "memory");
                asm volatile("global_store_dwordx4 %0, %1, off\n\ts_nop 1" :: "v"(op + 8), "v"(o1) : "memory");
            }
        }
        __syncthreads();
    }
#undef HG_LOAD
#undef HG_LD16
#undef HG_TIES
}
}

__global__ void __launch_bounds__(NTHREADS, 2) mega_fwd(Args args) {
    extern __shared__ __attribute__((aligned(16))) unsigned char lds_raw[];
    cg::grid_group grid = cg::this_grid();
    LAS unsigned char* lds = (LAS unsigned char*)lds_raw;
    const int tid = threadIdx.x, lane = tid & 63, wave = __builtin_amdgcn_readfirstlane(tid >> 6);
    const int G = gridDim.x, gw = blockIdx.x * NWAVES + wave, NGW = G * NWAVES;
    const float* x = args.in[0]; const float* ln1w = args.in[1]; const float* w_in = args.in[2];
    const float* qnw = args.in[3]; const float* knw = args.in[4];
    const float* lq1 = args.in[5]; const float* lk1 = args.in[6]; const float* lq2 = args.in[7]; const float* lk2 = args.in[8];
    const float* sublnw = args.in[9]; const float* lbl = args.in[10]; const float* hnw = args.in[11];
    const float* w_out = args.in[12]; const float* ln2w = args.in[13]; const float* w_up = args.in[14];
    const float* cw = args.in[15]; const float* cb = args.in[16]; const float* w_dn = args.in[17];
    unsigned char* ws = args.ws; float* out = args.out;
    bf16_t* WTin = (bf16_t*)(ws + WS_WIN); bf16_t* WTout = (bf16_t*)(ws + WS_WOUT); bf16_t* WTup = (bf16_t*)(ws + WS_WUP); bf16_t* WTdn = (bf16_t*)(ws + WS_WDN);
    float* SSQ = (float*)(ws + WS_SSQ); float* RS1 = (float*)(ws + WS_RS1);
    bf16_t* XN = (bf16_t*)(ws + WS_XN); bf16_t* PROJ = (bf16_t*)(ws + WS_PROJ); bf16_t* MIX = (bf16_t*)(ws + WS_MIX);
    float* ATT = (float*)(ws + WS_ATT); float* HG = (float*)(ws + WS_HG); bf16_t* X1B = (bf16_t*)(ws + WS_X1B); bf16_t* GB = (bf16_t*)(ws + WS_G);
    float* DL = (float*)(ws + WS_DL);
    float* UL = (float*)(ws + WS_UL); float* U01 = (float*)(ws + WS_U01); float* V01 = (float*)(ws + WS_V01);

    unsigned* ctl = (unsigned*)ws;
    if (tid < 16) ((volatile LAS unsigned*)(lds + LDS_MISC))[tid] = 0u;
    __syncthreads();
    if (args.ws == nullptr) grid.sync();
    const XcdBarrier bar = xcd_barrier_post(ctl + CW_BAR, (volatile LAS unsigned*)(lds + LDS_MISC));
    {
        LAS float* scr = (LAS float*)(lds + wave * 16384);
        constexpr int I_IN = (D / 64) * (NCOLS / 32);
        f32x4 wv[4];
#pragma unroll
        for (int j = 0; j < 4; ++j) wv[j] = ((const f32x4*)ln1w)[lane + 64 * j];
        f32x4 v0[4], v1[4];
        { const f32x4* xr0 = (const f32x4*)(x + (size_t)gw * D); const f32x4* xr1 = (const f32x4*)(x + (size_t)(gw + NGW) * D);
#pragma unroll
          for (int j = 0; j < 4; ++j) { v0[j] = xr0[lane + 64 * j]; v1[j] = xr1[lane + 64 * j]; } }
        for (int it = gw; it < I_IN; it += NGW) p0_transpose_item<2>(w_in, D, NCOLS, WTin, nullptr, scr, it, lane);
        for (int row = gw; row < M; row += 2 * NGW) {
            f32x4 n0[4], n1[4];
            const int nrow = row + 2 * NGW < M ? row + 2 * NGW : row;
            { const f32x4* xr0 = (const f32x4*)(x + (size_t)nrow * D); const f32x4* xr1 = (const f32x4*)(x + (size_t)(nrow + NGW) * D);
#pragma unroll
              for (int j = 0; j < 4; ++j) { n0[j] = xr0[lane + 64 * j]; n1[j] = xr1[lane + 64 * j]; } }
            float s0 = 0.f, s1 = 0.f;
#pragma unroll
            for (int j = 0; j < 4; ++j) { s0 += (v0[j].x * v0[j].x + v0[j].y * v0[j].y) + (v0[j].z * v0[j].z + v0[j].w * v0[j].w); s1 += (v1[j].x * v1[j].x + v1[j].y * v1[j].y) + (v1[j].z * v1[j].z + v1[j].w * v1[j].w); }
            const float ms0 = wave_sum(s0) * (1.f / D) + EPS, ms1 = wave_sum(s1) * (1.f / D) + EPS;
            const float r0 = rsqrtf(ms0), r1 = rsqrtf(ms1);
            if (lane == 0) { RS1[row] = ms0 * r0; RS1[row + NGW] = ms1 * r1; }
#pragma unroll
            for (int j = 0; j < 4; ++j) {
                uint2 o; o.x = pk2(v0[j].x * r0 * wv[j].x, v0[j].y * r0 * wv[j].y); o.y = pk2(v0[j].z * r0 * wv[j].z, v0[j].w * r0 * wv[j].w);
                ((uint2*)(XN + (size_t)row * D))[lane + 64 * j] = o;
                uint2 p; p.x = pk2(v1[j].x * r1 * wv[j].x, v1[j].y * r1 * wv[j].y); p.y = pk2(v1[j].z * r1 * wv[j].z, v1[j].w * r1 * wv[j].w);
                ((uint2*)(XN + (size_t)(row + NGW) * D))[lane + 64 * j] = p; }
#pragma unroll
            for (int j = 0; j < 4; ++j) { v0[j] = n0[j]; v1[j] = n1[j]; }
        }
    }
    xcd_barrier(bar);

    {
        pg8::Gemm g{XN, WTin, M, NCOLS, D, D}; pg8::StaticOrder So; So.init(M, NCOLS, G, (int)blockIdx.x);
        pg8::EpiProj E{PROJ, qnw, knw, QSCALE, lbl, DL, hnw};
        pg8::gemm_phase<pg8::EpiProj, pg8::StaticOrder, true>(lds, g, So, E);
    }
    xcd_barrier(bar);

    {
        if (blockIdx.x < 64) hg::hgrn_unit(lds, PROJ, MIX, DL, hnw, (int)blockIdx.x >> 2, (int)blockIdx.x & 3, tid, lane, wave);
        __syncthreads();
        if (wave >= 4) __builtin_amdgcn_s_setprio(1);
        {
            const float s1 = wave_sum(lq1[lane] * lk1[lane]), s2 = wave_sum(lq2[lane] * lk2[lane]);
            const float lam = __expf(s1) - __expf(s2) + LAM_INIT;
            LAS int* qslot = (LAS int*)(lds + fa::OFF_Q);
            int u = fa::attn_run(lds, PROJ, MIX, sublnw, ctl, lam, tid, lane, wave);
            for (;;) {
                constexpr int I_OUT = (D / 64) * (D / 32), I_UP = (D / 64) * (2 * DFF / 32), I_DN = (DFF / 64) * (D / 32), NCONV = (I_OUT + I_UP + I_DN + 7) / 8;
                if (u >= 1024 + NCONV) break;
                {
                    LAS float* scr = (LAS float*)(lds + wave * 16384);
                    int lane2 = lane; asm volatile("" : "+v"(lane2));
                    int r = (u - 1024) * 8 + wave;
                    if (r < I_OUT) p0_transpose_item<0>(w_out, D, D, WTout, nullptr, scr, r, lane2);
                    else if ((r -= I_OUT) < I_UP) p0_transpose_item<1>(w_up, D, 2 * DFF, WTup, ln2w, scr, r, lane2);
                    else if ((r -= I_UP) < I_DN) p0_transpose_item<0>(w_dn, DFF, D, WTdn, nullptr, scr, r, lane2);
                }
                if (tid == 0) *qslot = (int)__hip_atomic_fetch_add(ctl, 1u, __ATOMIC_RELAXED, __HIP_MEMORY_SCOPE_AGENT);
                __syncthreads();
                u = __builtin_amdgcn_readfirstlane(*qslot);
                __syncthreads();
            }
        }
        __builtin_amdgcn_s_setprio(0);
    }
    xcd_barrier(bar);

    {
        pg8::Gemm g{MIX, WTout, M, D, D, D}; pg8::StaticOrder So; So.init(M, D, G, (int)blockIdx.x);
        pg8::EpiResid<true, false, true, true> E{X1B, nullptr, X1B, SSQ, RS1, ln1w};
        pg8::gemm_phase<pg8::EpiResid<true, false, true, true>, pg8::StaticOrder, true>(lds, g, So, E);
    }
    xcd_barrier(bar);

    {
        pg8::Gemm g{X1B, WTup, M, 2 * DFF, D, D}; pg8::StaticOrder So; So.init(M, 2 * DFF, G, (int)blockIdx.x);
        LAS float* rtab = (LAS float*)(lds + RING_BYTES + 4096);
        {
          f32x4 sv[6][4]; bool ok[6];
#pragma unroll
          for (int k = 0; k < 6; ++k) { pg8::Unit un; const int ui = (tid >> 8) + 2 * k; ok[k] = ui < 11 && So.next(ui, un);
              const f32x4* sp = (const f32x4*)(SSQ + (size_t)((ok[k] ? un.pm : 0) * 256 + (tid & 255)) * 16);
#pragma unroll
              for (int q = 0; q < 4; ++q) sv[k][q] = sp[q]; }
#pragma unroll
          for (int k = 0; k < 6; ++k) if (ok[k]) {
              const f32x4 a = sv[k][0], b_ = sv[k][1], c_ = sv[k][2], d_ = sv[k][3];
              const float s = ((a[0] + a[1]) + (a[2] + a[3])) + ((b_[0] + b_[1]) + (b_[2] + b_[3])) + ((c_[0] + c_[1]) + (c_[2] + c_[3])) + ((d_[0] + d_[1]) + (d_[2] + d_[3]));
              rtab[tid + NTHREADS * k] = rsqrtf(s * (1.f / 1024.f) + EPS); }
          __syncthreads(); }
        pg8::EpiConvGlu E{GB, rtab, cw, cb, UL, U01, V01, (LAS float*)(lds + RING_BYTES)};
        pg8::gemm_phase<pg8::EpiConvGlu, pg8::StaticOrder, true>(lds, g, So, E);
    }
    xcd_barrier(bar);

    {
        pg8::Gemm g{GB, WTdn, M, D, DFF, DFF}; pg8::StaticOrder So; So.init(M, D, G, (int)blockIdx.x);
        pg8::Unit un;
        for (int ui = 0; So.next(ui, un); ++ui) {
            const int pm = un.pm;
            if ((pm & 7) == 0) continue;
            for (int e = tid; e < 2 * DFF; e += NTHREADS) {
                const int j = e / DFF, ch = e - j * DFF;
                const float ua = UL[((size_t)(pm - 1) * 2 + 0) * DFF + ch], ub = UL[((size_t)(pm - 1) * 2 + 1) * DFF + ch];
                const float u0 = U01[((size_t)pm * 2 + 0) * DFF + ch], u1 = U01[((size_t)pm * 2 + 1) * DFF + ch];
                const float um2 = j ? ub : ua, um1 = j ? u0 : ub, uc = j ? u1 : u0;
                const float c = cb[ch] + cw[ch] * um2 + cw[DFF + ch] * um1 + cw[2 * DFF + ch] * uc;
                GB[((size_t)pm * 256 + j) * DFF + ch] = (bf16_t)f2bf(c * sigmoidf_(c) * V01[((size_t)pm * 2 + j) * DFF + ch]);
            }
        }
        asm volatile("s_waitcnt vmcnt(0)" ::: "memory");
        __syncthreads();
        pg8::EpiResid<true, true, false> E{X1B, out, nullptr, nullptr, nullptr, nullptr};
        pg8::gemm_phase<pg8::EpiResid<true, true, false>, pg8::StaticOrder, true>(lds, g, So, E);
    }
}

extern "C" void kernel_launch(void* const* d_in, const int* in_sizes, int n_in, void* d_out, int out_size, void* d_ws, size_t ws_size, hipStream_t stream) {
    static int grid_blocks = 0;
    if (grid_blocks == 0) {
        if (n_in != 18 || in_sizes[0] != M * D || out_size != M * D || ws_size < WS_NEED) { fprintf(stderr, "kernel_launch: unexpected shapes: n_in %d in0 %d out %d ws %zu\n", n_in, n_in > 0 ? in_sizes[0] : -1, out_size, ws_size); grid_blocks = -1; return; }
        int dev = 0, cus = 0, per_cu = 0;
        if (hipGetDevice(&dev) != hipSuccess || hipDeviceGetAttribute(&cus, hipDeviceAttributeMultiprocessorCount, dev) != hipSuccess) { grid_blocks = -1; return; }
        if (hipFuncSetAttribute((const void*)mega_fwd, hipFuncAttributeMaxDynamicSharedMemorySize, LDS_BYTES) != hipSuccess) { fprintf(stderr, "kernel_launch: hipFuncSetAttribute failed\n"); grid_blocks = -1; return; }
        if (hipOccupancyMaxActiveBlocksPerMultiprocessor(&per_cu, (const void*)mega_fwd, NTHREADS, LDS_BYTES) != hipSuccess || per_cu < 1) { fprintf(stderr, "kernel_launch: occupancy query failed (%d)\n", per_cu); (void)hipGetLastError(); grid_blocks = -1; return; }
        grid_blocks = cus * (per_cu > 1 ? 1 : per_cu);
    }
    if (grid_blocks < 0) return;
    if (hipMemsetAsync(d_ws, 0, 65536, stream) != hipSuccess) { fprintf(stderr, "kernel_launch: hipMemsetAsync failed\n"); return; }
    Args a{};
    for (int i = 0; i < 18; ++i) a.in[i] = (const float*)d_in[i];
    a.out = (float*)d_out; a.ws = (unsigned char*)d_ws;
    void* kargs[] = {&a};
    hipError_t e = hipLaunchCooperativeKernel((const void*)mega_fwd, dim3(grid_blocks), dim3(NTHREADS), kargs, LDS_BYTES, stream);
    if (e != hipSuccess) fprintf(stderr, "cooperative launch failed: %s (grid %d)\n", hipGetErrorString(e), grid_blocks);
}
```

```cpp
#include <hip/hip_runtime.h>
#include <hip/hip_cooperative_groups.h>
#include <stdint.h>
#include <cstdio>
namespace cg = cooperative_groups;

constexpr int D = 1024, NB = 16, S = 2048, M = NB * S;
constexpr int NH = 4, NCOLS = 3584, DFF = 2816;
constexpr int OFF_DQ = 0, OFF_DK = 512, OFF_DV = 1024, OFF_HQ = 1536, OFF_HF = 2048, OFF_HI = 2560, OFF_HG = 3072;
constexpr float EPS = 1e-6f;
constexpr float LAM_INIT = 0.2f;

namespace pg8 {
#define PG8_LAS __attribute__((address_space(3)))
typedef unsigned short bf16_t;
typedef short bf16x8 __attribute__((ext_vector_type(8)));
typedef float f32x4 __attribute__((ext_vector_type(4)));
typedef unsigned u32x4 __attribute__((ext_vector_type(4)));
constexpr int BM = 256, BK = 64, HALF = 128, HTB = HALF * BK * 2, STAGE_BYTES = 8 * HTB, NXCD = 8, WGM = 8;

__host__ __device__ __forceinline__ int lds_byte(int r, int c) { const int st = (r >> 4) * 2 + (c >> 5), rr = r & 15, cc = c & 31, ob = rr * 64 + cc * 2; return st * 1024 + (ob ^ (((ob >> 9) & 1) << 5)); }
__host__ __device__ __forceinline__ void stage_rc(int b, int& R, int& C) { const int st = b / 1024, sb = b % 1024, swz = sb ^ (((sb >> 9) & 1) << 5); R = (st >> 1) * 16 + swz / 64; C = (st & 1) * 32 + (swz % 64) / 2; }
__host__ __device__ __forceinline__ int perm32(int rho) { const int n = rho >> 4, i = rho & 15; return 8 * (i >> 2) + 4 * n + (i & 3); }

struct Unit { int pm, pn; };
struct Gemm { const bf16_t* A; const bf16_t* Bt; int M, N, K, lda; };

struct StaticOrder {
    int nM, nN, nwg, G, c;
    __host__ __device__ void init(int M_, int N_, int G_, int c_) { nM = M_ / BM; nN = N_ / BM; nwg = nM * nN; G = G_; c = c_; }
    __host__ __device__ bool next(int i, Unit& u) const {
        const long L = (long)i * G + c; if (L >= nwg) return false;
        int wgid = (int)L; { const int q = nwg / NXCD, r = nwg % NXCD, xcd = wgid % NXCD, off = wgid / NXCD; wgid = (xcd < r ? xcd * (q + 1) : r * (q + 1) + (xcd - r) * q) + off; }
        const int nig = WGM * nN, gid = wgid / nig, fm = gid * WGM, gsz = (nM - fm) < WGM ? (nM - fm) : WGM;
        u.pm = fm + ((wgid % nig) % gsz); u.pn = (wgid % nig) / gsz; return true;
    }
    __device__ __forceinline__ void a_ready(const Unit&) const {}
    __device__ __forceinline__ void done(const Unit&) const {}
};

__device__ __forceinline__ unsigned cvt_pk_bf16(float lo, float hi) { unsigned r; asm volatile("v_cvt_pk_bf16_f32 %0, %1, %2" : "=v"(r) : "v"(lo), "v"(hi)); return r; }
typedef unsigned st_u32x4 __attribute__((ext_vector_type(4)));
typedef float st_f32x4 __attribute__((ext_vector_type(4)));
__device__ __forceinline__ void st_nt(void* p, st_u32x4 v) { __builtin_nontemporal_store(v, (st_u32x4*)p); }
__device__ __forceinline__ void st_nt(void* p, st_f32x4 v) { __builtin_nontemporal_store(v, (st_f32x4*)p); }


struct EpiBf16 {
    static constexpr bool PERM = true, AFTER_DRAIN = false;
    bf16_t* O; int ldc; const float* ssq;
    __device__ __forceinline__ void operator()(const f32x4 (&acc)[2][2][4][2], const Unit& u, int wr, int wc, int fr, int fq, int ui) const {
        const int row0 = u.pm * BM + wr * 64 + fr, col0 = u.pn * BM + wc * 32 + 8 * fq;
#pragma unroll
        for (int ai = 0; ai < 2; ++ai)
#pragma unroll
            for (int m = 0; m < 4; ++m) {
                const int row = row0 + ai * HALF + m * 16;
                float sc = 1.f;
                if (ssq) { const f32x4* sp = (const f32x4*)(ssq + (size_t)row * 16); const f32x4 a = sp[0], b = sp[1], c = sp[2], d = sp[3];
                    const float s = ((a[0] + a[1]) + (a[2] + a[3])) + ((b[0] + b[1]) + (b[2] + b[3])) + ((c[0] + c[1]) + (c[2] + c[3])) + ((d[0] + d[1]) + (d[2] + d[3]));
                    sc = rsqrtf(s * (1.f / 1024.f) + EPS); }
                bf16_t* rowp = O + (size_t)row * ldc + col0;
#pragma unroll
                for (int bj = 0; bj < 2; ++bj) { const f32x4 v0 = acc[ai][bj][m][0] * sc, v1 = acc[ai][bj][m][1] * sc;
                    u32x4 w; w.x = cvt_pk_bf16(v0[0], v0[1]); w.y = cvt_pk_bf16(v0[2], v0[3]); w.z = cvt_pk_bf16(v1[0], v1[1]); w.w = cvt_pk_bf16(v1[2], v1[3]);
                    *(u32x4*)(rowp + bj * HALF) = w; }
            }
    }
};

struct EpiProj {
    static constexpr bool PERM = true, AFTER_DRAIN = false;
    bf16_t* O; const float* qw; const float* kw; float qscale; const float* lbl; float* DL; const float* hnw;
    __device__ __forceinline__ void operator()(const f32x4 (&acc)[2][2][4][2], const Unit& u, int wr, int wc, int fr, int fq, int ui) const {
        const int row0 = u.pm * BM + wr * 64 + fr;
        if (u.pn < 4) {
            const float* w = (u.pn < 2) ? qw : kw; const float sc = (u.pn < 2) ? qscale : 1.f;
            const int col0 = u.pn * BM + 64 * wc + 8 * fq;
            f32x4 wq0[2], wq1[2];
#pragma unroll
            for (int bj = 0; bj < 2; ++bj) { wq0[bj] = *(const f32x4*)(w + 32 * bj + 8 * fq); wq1[bj] = *(const f32x4*)(w + 32 * bj + 8 * fq + 4); }
            float rr[2][4];
#pragma unroll
            for (int ai = 0; ai < 2; ++ai)
#pragma unroll
                for (int m = 0; m < 4; ++m) {
                    float ss = 0.f;
#pragma unroll
                    for (int bj = 0; bj < 2; ++bj)
#pragma unroll
                        for (int n = 0; n < 2; ++n) { const f32x4 v = acc[ai][bj][m][n]; ss += (v[0] * v[0] + v[1] * v[1]) + (v[2] * v[2] + v[3] * v[3]); }
                    ss += __shfl_xor(ss, 16); ss += __shfl_xor(ss, 32);
                    rr[ai][m] = rsqrtf(ss * (1.f / 64.f) + EPS) * sc;
                }
#pragma unroll
            for (int bj = 0; bj < 2; ++bj) {
                const f32x4 w0 = wq0[bj], w1 = wq1[bj];
#pragma unroll
                for (int ai = 0; ai < 2; ++ai)
#pragma unroll
                    for (int m = 0; m < 4; ++m) {
                        const f32x4 v0 = acc[ai][bj][m][0] * rr[ai][m] * w0, v1 = acc[ai][bj][m][1] * rr[ai][m] * w1;
                        u32x4 o; o.x = cvt_pk_bf16(v0[0], v0[1]); o.y = cvt_pk_bf16(v0[2], v0[3]); o.z = cvt_pk_bf16(v1[0], v1[1]); o.w = cvt_pk_bf16(v1[2], v1[3]);
                        st_nt(O + (size_t)(row0 + ai * HALF + m * 16) * NCOLS + col0 + 32 * bj, o);
                    }
                asm volatile("" ::: "memory");
            }
        } else if (u.pn >= 6 && u.pn < 10) {
            const int h = u.pn - 6, k0 = wc * 32 + 8 * fq, lane_ = fq * 16 + fr, ad15 = (lane_ | 15) << 2;
#define EP_DPP_MUL(x, ctrl) x *= __int_as_float(__builtin_amdgcn_update_dpp(0x3f800000, __float_as_int(x), ctrl, 0xf, 0xf, false))
            f32x4 lb[2];
#pragma unroll
            for (int n = 0; n < 2; ++n) { const f32x4 l0 = *(const f32x4*)(lbl + h * 128 + k0 + 4 * n), l1 = *(const f32x4*)(lbl + 512 + h * 128 + k0 + 4 * n);
#pragma unroll
                for (int i = 0; i < 4; ++i) lb[n][i] = __builtin_amdgcn_rcpf(1.f + __builtin_amdgcn_exp2f((l1[i] - l0[i]) * 1.4426950408889634f)); }
#pragma unroll
            for (int ai = 0; ai < 2; ++ai) {
                f32x4 bc[2][4], om[2][4];
#pragma unroll
                for (int n = 0; n < 2; ++n) {
#pragma unroll
                    for (int m = 0; m < 4; ++m)
#pragma unroll
                        for (int i = 0; i < 4; ++i) {
                            const float z = acc[ai][1][m][n][i];
                            const float f = lb[n][i] + (1.f - lb[n][i]) * __builtin_amdgcn_rcpf(1.f + __builtin_amdgcn_exp2f(-1.4426950408889634f * z));
                            om[n][m][i] = 1.f - f; bc[n][m][i] = f;
                        }
#pragma unroll
                    for (int m = 0; m < 4; ++m)
#pragma unroll
                        for (int i = 0; i < 4; ++i) { EP_DPP_MUL(bc[n][m][i], 0x111); EP_DPP_MUL(bc[n][m][i], 0x112); EP_DPP_MUL(bc[n][m][i], 0x114); EP_DPP_MUL(bc[n][m][i], 0x118); }
#pragma unroll
                    for (int m = 1; m < 4; ++m)
#pragma unroll
                        for (int i = 0; i < 4; ++i) bc[n][m][i] *= __int_as_float(__builtin_amdgcn_ds_bpermute(ad15, __float_as_int(bc[n][m - 1][i])));
                }
                const int rc = u.pm * BM + ai * HALF + wr * 64;
#pragma unroll
                for (int m = 0; m < 4; ++m) {
                    unsigned wq[4], wk[4];
#pragma unroll
                    for (int n = 0; n < 2; ++n) {
                        const f32x4 q = acc[ai][0][m][n];
                        float qt[4], kt[4];
#pragma unroll
                        for (int i = 0; i < 4; ++i) { qt[i] = q[i] * bc[n][m][i]; kt[i] = om[n][m][i] * __builtin_amdgcn_rcpf(bc[n][m][i]); }
                        wq[2 * n] = cvt_pk_bf16(qt[0], qt[1]); wq[2 * n + 1] = cvt_pk_bf16(qt[2], qt[3]); wk[2 * n] = cvt_pk_bf16(kt[0], kt[1]); wk[2 * n + 1] = cvt_pk_bf16(kt[2], kt[3]);
                    }
                    bf16_t* rp = O + (size_t)(rc + m * 16 + fr) * NCOLS + h * 128 + k0;
                    st_nt(rp + OFF_HQ, (u32x4){wq[0], wq[1], wq[2], wq[3]});
                    st_nt(rp + OFF_HF, (u32x4){wk[0], wk[1], wk[2], wk[3]});
                }
                if (fr == 15) {
                    float* dp = DL + (size_t)(((rc >> 11) * 4 + h) * 32 + ((rc & 2047) >> 6)) * 128 + k0;
                    *(f32x4*)dp = bc[0][3]; *(f32x4*)(dp + 4) = bc[1][3];
                }
                asm volatile("" ::: "memory");
            }
#undef EP_DPP_MUL
        } else if (u.pn >= 12) {
            const int col0 = u.pn * BM + wc * 32 + 8 * fq;
            const f32x4 w0 = *(const f32x4*)(hnw + wc * 32 + 8 * fq), w1 = *(const f32x4*)(hnw + wc * 32 + 8 * fq + 4);
#pragma unroll
            for (int ai = 0; ai < 2; ++ai)
#pragma unroll
                for (int m = 0; m < 4; ++m) {
                    bf16_t* rowp = O + (size_t)(row0 + ai * HALF + m * 16) * NCOLS + col0;
#pragma unroll
                    for (int bj = 0; bj < 2; ++bj) { f32x4 v0 = acc[ai][bj][m][0], v1 = acc[ai][bj][m][1];
#pragma unroll
                        for (int i = 0; i < 4; ++i) { v0[i] *= w0[i] * __builtin_amdgcn_rcpf(1.f + __builtin_amdgcn_exp2f(-1.4426950408889634f * v0[i]));
                                                      v1[i] *= w1[i] * __builtin_amdgcn_rcpf(1.f + __builtin_amdgcn_exp2f(-1.4426950408889634f * v1[i])); }
                        u32x4 o; o.x = cvt_pk_bf16(v0[0], v0[1]); o.y = cvt_pk_bf16(v0[2], v0[3]); o.z = cvt_pk_bf16(v1[0], v1[1]); o.w = cvt_pk_bf16(v1[2], v1[3]);
                        st_nt(rowp + bj * HALF, o); }
                }
        } else {
            const int col0 = u.pn * BM + wc * 32 + 8 * fq;
#pragma unroll
            for (int ai = 0; ai < 2; ++ai)
#pragma unroll
                for (int m = 0; m < 4; ++m) {
                    bf16_t* rowp = O + (size_t)(row0 + ai * HALF + m * 16) * NCOLS + col0;
#pragma unroll
                    for (int bj = 0; bj < 2; ++bj) { const f32x4 v0 = acc[ai][bj][m][0], v1 = acc[ai][bj][m][1];
                        u32x4 o; o.x = cvt_pk_bf16(v0[0], v0[1]); o.y = cvt_pk_bf16(v0[2], v0[3]); o.z = cvt_pk_bf16(v1[0], v1[1]); o.w = cvt_pk_bf16(v1[2], v1[3]);
                        st_nt(rowp + bj * HALF, o); }
                }
        }
    }
};

template <bool BF16BASE, bool F32OUT, bool XBOUT, bool SCALED = false>
struct EpiResid {
    static constexpr bool PERM = true, AFTER_DRAIN = false;
    const void* base; float* out; bf16_t* xb; float* ssq; const float* rscale; const float* cw;
    __device__ __forceinline__ void operator()(const f32x4 (&acc)[2][2][4][2], const Unit& u, int wr, int wc, int fr, int fq, int ui) const {
        const int row0 = u.pm * BM + wr * 64 + fr, col0 = u.pn * BM + wc * 32 + 8 * fq;
        f32x4 ic[2][2];
        if (SCALED) {
#pragma unroll
            for (int bj = 0; bj < 2; ++bj)
#pragma unroll
                for (int n = 0; n < 2; ++n) { const f32x4 w = *(const f32x4*)(cw + col0 + bj * HALF + 4 * n); ic[bj][n] = (f32x4){__builtin_amdgcn_rcpf(w[0]), __builtin_amdgcn_rcpf(w[1]), __builtin_amdgcn_rcpf(w[2]), __builtin_amdgcn_rcpf(w[3])}; }
        }
#pragma unroll
        for (int ai = 0; ai < 2; ++ai) {
            u32x4 pb[4][2]; f32x4 pf[4][2][2]; float rsc[4];
            if (SCALED) {
#pragma unroll
                for (int m = 0; m < 4; ++m) rsc[m] = rscale[row0 + ai * HALF + m * 16];
            }
#pragma unroll
            for (int m = 0; m < 4; ++m)
#pragma unroll
                for (int bj = 0; bj < 2; ++bj) { const size_t off = (size_t)(row0 + ai * HALF + m * 16) * D + col0 + bj * HALF;
                    if (BF16BASE) pb[m][bj] = *(const u32x4*)((const bf16_t*)base + off);
                    else { pf[m][bj][0] = *(const f32x4*)((const float*)base + off); pf[m][bj][1] = *(const f32x4*)((const float*)base + off + 4); } }
#pragma unroll
            for (int m = 0; m < 4; ++m) {
                const int row = row0 + ai * HALF + m * 16; const size_t off = (size_t)row * D + col0;
                float ss = 0.f;
#pragma unroll
                for (int bj = 0; bj < 2; ++bj) {
                    f32x4 b0, b1;
                    if (BF16BASE) { const u32x4 w = pb[m][bj];
                        b0 = (f32x4){__uint_as_float(w.x << 16), __uint_as_float(w.x & 0xffff0000u), __uint_as_float(w.y << 16), __uint_as_float(w.y & 0xffff0000u)};
                        b1 = (f32x4){__uint_as_float(w.z << 16), __uint_as_float(w.z & 0xffff0000u), __uint_as_float(w.w << 16), __uint_as_float(w.w & 0xffff0000u)}; }
                    else { b0 = pf[m][bj][0]; b1 = pf[m][bj][1]; }
                    if (SCALED) { b0 = b0 * rsc[m] * ic[bj][0]; b1 = b1 * rsc[m] * ic[bj][1]; }
                    const f32x4 v0 = acc[ai][bj][m][0] + b0, v1 = acc[ai][bj][m][1] + b1;
                    if (F32OUT) { st_nt(out + off + bj * HALF, v0); st_nt(out + off + bj * HALF + 4, v1); }
                    if (XBOUT) { u32x4 w; w.x = cvt_pk_bf16(v0[0], v0[1]); w.y = cvt_pk_bf16(v0[2], v0[3]); w.z = cvt_pk_bf16(v1[0], v1[1]); w.w = cvt_pk_bf16(v1[2], v1[3]); st_nt(xb + off + bj * HALF, w);
                        ss += ((v0[0] * v0[0] + v0[1] * v0[1]) + (v0[2] * v0[2] + v0[3] * v0[3])) + ((v1[0] * v1[0] + v1[1] * v1[1]) + (v1[2] * v1[2] + v1[3] * v1[3])); }
                }
                if (XBOUT) { ss += __shfl_xor(ss, 16); ss += __shfl_xor(ss, 32); if (fq == 0) ssq[(size_t)row * 16 + u.pn * 4 + wc] = ss; }
            }
            asm volatile("" ::: "memory");
        }
    }
};

struct EpiConvGlu {
    static constexpr bool PERM = true, AFTER_DRAIN = false;
    bf16_t* G; const PG8_LAS float* rtab; const float* cw; const float* cb; float* UL; float* U01; float* V01; PG8_LAS float* hx;
    __device__ __forceinline__ void operator()(const f32x4 (&acc)[2][2][4][2], const Unit& u, int wr, int wc, int fr, int fq, int ui) const {
        const int ch0 = u.pn * HALF + wc * 32 + 8 * fq, row0 = u.pm * BM + wr * 64 + fr;
        f32x4 cbv[2], w0v[2], w1v[2], w2v[2];
#pragma unroll
        for (int n = 0; n < 2; ++n) { cbv[n] = *(const f32x4*)(cb + ch0 + 4 * n); w0v[n] = *(const f32x4*)(cw + ch0 + 4 * n); w1v[n] = *(const f32x4*)(cw + DFF + ch0 + 4 * n); w2v[n] = *(const f32x4*)(cw + 2 * DFF + ch0 + 4 * n); }
        float rs[2][4];
#pragma unroll
        for (int ai = 0; ai < 2; ++ai)
#pragma unroll
            for (int m = 0; m < 4; ++m) rs[ai][m] = rtab[ui * BM + ai * HALF + wr * 64 + m * 16 + fr];
#pragma unroll
        for (int ai = 0; ai < 2; ++ai) {
            if (fr >= 14) {
                PG8_LAS float* hp = hx + ((2 * ai + wr) * 4 + wc) * 64 + (fr - 14) * 32 + 8 * fq;
                *(PG8_LAS f32x4*)hp = acc[ai][0][3][0] * rs[ai][3]; *(PG8_LAS f32x4*)(hp + 4) = acc[ai][0][3][1] * rs[ai][3];
            }
        }
        if (wr == 1 && fr >= 14) { float* p = UL + ((size_t)u.pm * 2 + (fr - 14)) * DFF + ch0; *(f32x4*)p = acc[1][0][3][0] * rs[1][3]; *(f32x4*)(p + 4) = acc[1][0][3][1] * rs[1][3]; }
        if (wr == 0 && fr < 2) { float* p = U01 + ((size_t)u.pm * 2 + fr) * DFF + ch0; *(f32x4*)p = acc[0][0][0][0] * rs[0][0]; *(f32x4*)(p + 4) = acc[0][0][0][1] * rs[0][0];
                                 float* q = V01 + ((size_t)u.pm * 2 + fr) * DFF + ch0; *(f32x4*)q = acc[0][1][0][0] * rs[0][0]; *(f32x4*)(q + 4) = acc[0][1][0][1] * rs[0][0]; }
        asm volatile("s_waitcnt lgkmcnt(0)" ::: "memory"); __builtin_amdgcn_s_barrier(); asm volatile("" ::: "memory");
        const int lane = fq * 16 + fr;
        const bool is15 = (fr == 15), ge14 = (fr >= 14);
        typedef _Float16 h2 __attribute__((ext_vector_type(2)));
#define CG_PK(a_, b_) __builtin_bit_cast(h2, __builtin_amdgcn_cvt_pkrtz((a_), (b_)))
        const h2 mL2 = {(_Float16)-1.4426950408889634f, (_Float16)-1.4426950408889634f}, one2 = {(_Float16)1.f, (_Float16)1.f};
        h2 cb2[2][2], w02[2][2], w12[2][2], w22[2][2];
#pragma unroll
        for (int n = 0; n < 2; ++n)
#pragma unroll
            for (int p = 0; p < 2; ++p) { cb2[n][p] = CG_PK(cbv[n][2 * p], cbv[n][2 * p + 1]); w02[n][p] = CG_PK(w0v[n][2 * p], w0v[n][2 * p + 1]); w12[n][p] = CG_PK(w1v[n][2 * p], w1v[n][2 * p + 1]); w22[n][p] = CG_PK(w2v[n][2 * p], w2v[n][2 * p + 1]); }
#pragma unroll
        for (int ai = 0; ai < 2; ++ai) {
            const int gi = 2 * ai + wr;
            h2 prev[2][2];
#pragma unroll
            for (int n = 0; n < 2; ++n) {
                prev[n][0] = (h2){(_Float16)0.f, (_Float16)0.f}; prev[n][1] = prev[n][0];
                if (gi != 0) { const f32x4 pf_ = *(const PG8_LAS f32x4*)(hx + ((gi - 1) * 4 + wc) * 64 + (fr & 1) * 32 + 8 * fq + 4 * n); prev[n][0] = CG_PK(pf_[0], pf_[1]); prev[n][1] = CG_PK(pf_[2], pf_[3]); }
            }
#pragma unroll
            for (int m = 0; m < 4; ++m) {
                const float r_ = rs[ai][m]; const h2 r2 = {(_Float16)r_, (_Float16)r_};
                unsigned w[4];
#pragma unroll
                for (int n = 0; n < 2; ++n) {
                    const f32x4 uf = acc[ai][0][m][n], vf_ = acc[ai][1][m][n];
#pragma unroll
                    for (int p = 0; p < 2; ++p) {
                        const h2 cur = CG_PK(uf[2 * p], uf[2 * p + 1]) * r2;
                        const h2 vv = CG_PK(vf_[2 * p], vf_[2 * p + 1]) * r2;
                        const int ci = __builtin_bit_cast(int, cur), pi = __builtin_bit_cast(int, prev[n][p]);
                        const h2 s1 = __builtin_bit_cast(h2, __builtin_amdgcn_update_dpp(0, is15 ? pi : ci, 0x121, 0xf, 0xf, false));
                        const h2 s2 = __builtin_bit_cast(h2, __builtin_amdgcn_update_dpp(0, ge14 ? pi : ci, 0x122, 0xf, 0xf, false));
                        const h2 c = cb2[n][p] + w02[n][p] * s2 + w12[n][p] * s1 + w22[n][p] * cur;
                        const h2 t = c * mL2;
                        h2 e2; e2[0] = (_Float16)__builtin_exp2f16(t[0]); e2[1] = (_Float16)__builtin_exp2f16(t[1]);
                        const h2 d = e2 + one2;
                        h2 sg; sg[0] = (_Float16)__builtin_amdgcn_rcph(d[0]); sg[1] = (_Float16)__builtin_amdgcn_rcph(d[1]);
                        const h2 g2 = c * sg * vv;
                        w[2 * n + p] = cvt_pk_bf16((float)g2[0], (float)g2[1]);
                        prev[n][p] = cur;
                    }
                }
                st_nt(G + (size_t)(row0 + ai * HALF + m * 16) * DFF + ch0, (u32x4){w[0], w[1], w[2], w[3]});
                asm volatile("" ::: "memory");
            }
        }
#undef CG_PK
    }
};

template <class Epi, class Sched, bool ALIGN_EPI>
__device__ __forceinline__ void gemm_phase(PG8_LAS unsigned char* lds, const Gemm g, const Sched& S, const Epi& E) {
    int tid = threadIdx.x; asm volatile("" : "+v"(tid));
    const int wid = __builtin_amdgcn_readfirstlane(tid >> 6), lane = tid & 63, wr = wid >> 2, wc = wid & 3, fr = lane & 15, fq = lane >> 4;
    const int K = g.K, nt = K / BK, lda = g.lda;
    unsigned voffA[2], voffB[2];
#pragma unroll
    for (int i = 0; i < 2; ++i) { int R, C; stage_rc(tid * 16 + i * 8192, R, C); const int Rb = Epi::PERM ? ((R & ~31) + perm32(R & 31)) : R;
        voffA[i] = (unsigned)(R * lda + C) * 2u; voffB[i] = (unsigned)(Rb * K + C) * 2u; }
    const size_t kstep = (size_t)(BK * 2);
    const size_t hstepA = (size_t)HALF * lda * 2, hstepB = (size_t)HALF * K * 2;
    const size_t tstepA = 2 * hstepA, tstepB = 2 * hstepB;
    const unsigned ldsw = (unsigned)wid * 1024u;
    const int aoff = lds_byte(wr * 64 + fr, fq * 8), boff = lds_byte(wc * 32 + fr, fq * 8);
#define PG8_SA(b, h) (((b) * 2 + (h)) * HTB)
#define PG8_SB(b, h) ((4 + (b) * 2 + (h)) * HTB)
#define PG8_STAGE(bufoff, gbase, voff) do { _Pragma("unroll") for (int _i = 0; _i < 2; ++_i) \
        __builtin_amdgcn_global_load_lds((const unsigned*)((const char*)(gbase) + (voff)[_i]), (PG8_LAS unsigned*)(lds + (bufoff) + ldsw + _i * 8192), 16, 0, 0); } while (0)
#define PG8_LDA(dst, b, h) do { _Pragma("unroll") for (int m = 0; m < 4; ++m) _Pragma("unroll") for (int k = 0; k < 2; ++k) dst[m][k] = *(const PG8_LAS bf16x8*)(lds + PG8_SA(b, h) + aoff + m * 2048 + k * 1024); } while (0)
#define PG8_LDB(dst, b, h) do { _Pragma("unroll") for (int n = 0; n < 2; ++n) _Pragma("unroll") for (int k = 0; k < 2; ++k) dst[n][k] = *(const PG8_LAS bf16x8*)(lds + PG8_SB(b, h) + boff + n * 2048 + k * 1024); } while (0)
#define PG8_MMA(ai, bj, At, Bt) do { __builtin_amdgcn_s_setprio(1); _Pragma("unroll") for (int m = 0; m < 4; ++m) _Pragma("unroll") for (int n = 0; n < 2; ++n) _Pragma("unroll") for (int k = 0; k < 2; ++k) \
        acc[ai][bj][m][n] = __builtin_amdgcn_mfma_f32_16x16x32_bf16(Bt[n][k], At[m][k], acc[ai][bj][m][n], 0, 0, 0); __builtin_amdgcn_s_setprio(0); } while (0)
#define PG8_WAIT_V(n) asm volatile("s_waitcnt vmcnt(" #n ")" ::: "memory")
#define PG8_WAIT_L(n) asm volatile("s_waitcnt lgkmcnt(" #n ")" ::: "memory")
#define PG8_BAR __builtin_amdgcn_s_barrier()
#define PG8_SCHED __builtin_amdgcn_sched_barrier(0)
    Unit cur, nxt; int ui = 0;
    if (!S.next(0, cur)) return;
    f32x4 acc[2][2][4][2];
#pragma unroll
    for (int a = 0; a < 2; ++a)
#pragma unroll
        for (int b = 0; b < 2; ++b)
#pragma unroll
            for (int m = 0; m < 4; ++m)
#pragma unroll
                for (int n = 0; n < 2; ++n) acc[a][b][m][n] = (f32x4){0.f, 0.f, 0.f, 0.f};
    bf16x8 At[4][2], B0[2][2], B1[2][2];
    const char* cA = (const char*)g.A + (size_t)cur.pm * tstepA; const char* cB = (const char*)g.Bt + (size_t)cur.pn * tstepB;
    S.a_ready(cur);
    PG8_STAGE(PG8_SB(0, 0), cB, voffB); PG8_STAGE(PG8_SB(0, 1), cB + hstepB, voffB); PG8_STAGE(PG8_SA(0, 0), cA, voffA); PG8_STAGE(PG8_SA(0, 1), cA + hstepA, voffA);
    if (wr == 1) PG8_BAR;
    PG8_WAIT_V(2); PG8_BAR;
    PG8_STAGE(PG8_SB(1, 0), cB + kstep, voffB); PG8_STAGE(PG8_SA(1, 0), cA + kstep, voffA); PG8_STAGE(PG8_SB(1, 1), cB + hstepB + kstep, voffB);
    PG8_WAIT_V(6); PG8_BAR;
    for (;;) {
        const bool has_next = S.next(ui + 1, nxt);
        const char* nA = has_next ? (const char*)g.A + (size_t)nxt.pm * tstepA : cA; const char* nB = has_next ? (const char*)g.Bt + (size_t)nxt.pn * tstepB : cB;
        for (int t = 0; t < nt; t += 2) {
            const bool last = (t == nt - 2);
            const char* a1 = cA + (size_t)(t + 1) * kstep;
            const char* a2 = last ? nA : cA + (size_t)(t + 2) * kstep; const char* b2 = last ? nB : cB + (size_t)(t + 2) * kstep;
            const char* a3 = a2 + kstep; const char* b3 = b2 + kstep;
            if (last && has_next) S.a_ready(nxt);
            PG8_LDB(B0, 0, 0); PG8_LDB(B1, 0, 1); PG8_SCHED; PG8_LDA(At, 0, 0); PG8_STAGE(PG8_SA(1, 1), a1 + hstepA, voffA);
            PG8_WAIT_V(8); PG8_WAIT_L(0); PG8_BAR; PG8_MMA(0, 0, At, B0); PG8_MMA(0, 1, At, B1); PG8_BAR; PG8_SCHED;
            PG8_LDA(At, 0, 1); PG8_STAGE(PG8_SB(0, 0), b2, voffB); PG8_STAGE(PG8_SB(0, 1), b2 + hstepB, voffB); PG8_STAGE(PG8_SA(0, 0), a2, voffA);
            PG8_WAIT_V(8); PG8_WAIT_L(0); PG8_BAR; PG8_MMA(1, 0, At, B0); PG8_MMA(1, 1, At, B1); PG8_BAR; PG8_SCHED;
            PG8_LDB(B0, 1, 0); PG8_LDB(B1, 1, 1); PG8_SCHED; PG8_LDA(At, 1, 0); PG8_STAGE(PG8_SA(0, 1), a2 + hstepA, voffA);
            PG8_WAIT_V(8); PG8_WAIT_L(0); PG8_BAR; PG8_MMA(0, 0, At, B0); PG8_MMA(0, 1, At, B1); PG8_BAR; PG8_SCHED;
            PG8_LDA(At, 1, 1); PG8_STAGE(PG8_SB(1, 0), b3, voffB); PG8_STAGE(PG8_SB(1, 1), b3 + hstepB, voffB); PG8_STAGE(PG8_SA(1, 0), a3, voffA);
            PG8_WAIT_V(8); PG8_WAIT_L(0); PG8_BAR; PG8_MMA(1, 0, At, B0); PG8_MMA(1, 1, At, B1); PG8_BAR; PG8_SCHED;
        }
        if constexpr (ALIGN_EPI) { if (wr == 0) PG8_BAR; }
        E(acc, cur, wr, wc, fr, fq, ui); S.done(cur);
        if (!has_next) break;
#pragma unroll
        for (int a = 0; a < 2; ++a)
#pragma unroll
            for (int b = 0; b < 2; ++b)
#pragma unroll
                for (int m = 0; m < 4; ++m)
#pragma unroll
                    for (int n = 0; n < 2; ++n) acc[a][b][m][n] = (f32x4){0.f, 0.f, 0.f, 0.f};
        cur = nxt; cA = nA; cB = nB; ++ui;
        if constexpr (ALIGN_EPI) { if (wr == 1) PG8_BAR; }
    }
    PG8_WAIT_V(0);
    if constexpr (!ALIGN_EPI) { if (wr == 0) PG8_BAR; }
    PG8_BAR;
#undef PG8_SA
#undef PG8_SB
#undef PG8_STAGE
#undef PG8_LDA
#undef PG8_LDB
#undef PG8_MMA
#undef PG8_WAIT_V
#undef PG8_WAIT_L
#undef PG8_BAR
#undef PG8_SCHED
}
}

#define LAS __attribute__((address_space(3)))
typedef unsigned short bf16_t;
typedef float f32x4 __attribute__((ext_vector_type(4)));
typedef unsigned u32x4 __attribute__((ext_vector_type(4)));
typedef unsigned u32x2 __attribute__((ext_vector_type(2)));
constexpr int NWAVES = 8, NTHREADS = 512;
constexpr int LDS_BYTES = 147456;
constexpr int RING_BYTES = 131072;

constexpr size_t MiB = 1u << 20;
constexpr size_t WS_WIN = 1 * MiB, WS_WOUT = 9 * MiB, WS_WUP = 12 * MiB, WS_WDN = 24 * MiB;
constexpr size_t WS_RS1 = 29 * MiB + 768 * 1024;
constexpr size_t WS_SSQ = 30 * MiB;
constexpr size_t WS_XN = 32 * MiB;
constexpr size_t WS_HG = 32 * MiB;
constexpr size_t WS_X1B = 32 * MiB;
constexpr size_t WS_PROJ = 96 * MiB;
constexpr size_t WS_MIX = 320 * MiB;
constexpr size_t WS_ATT = 384 * MiB;
constexpr size_t WS_G = 96 * MiB;
constexpr size_t WS_UL = 272 * MiB, WS_U01 = 275 * MiB, WS_V01 = 278 * MiB;
constexpr size_t WS_DL = 384 * MiB;
constexpr size_t WS_NEED = 512 * MiB;

__device__ __forceinline__ unsigned f2bf(float f) { unsigned u = __float_as_uint(f); return (u + 0x7fffu + ((u >> 16) & 1u)) >> 16; }
__device__ __forceinline__ unsigned pk2(float lo, float hi) { return f2bf(lo) | (f2bf(hi) << 16); }
__device__ __forceinline__ float bf2f(unsigned h) { return __uint_as_float(h << 16); }
#define WS_DPP_ADD(x, ctrl, rmask) x += __int_as_float(__builtin_amdgcn_update_dpp(0, __float_as_int(x), ctrl, rmask, 0xf, true))
__device__ __forceinline__ float wave_sum(float v) {
    WS_DPP_ADD(v, 0x111, 0xf); WS_DPP_ADD(v, 0x112, 0xf); WS_DPP_ADD(v, 0x114, 0xf); WS_DPP_ADD(v, 0x118, 0xf);
    WS_DPP_ADD(v, 0x142, 0xa); WS_DPP_ADD(v, 0x143, 0xc);
    return __int_as_float(__builtin_amdgcn_readlane(__float_as_int(v), 63));
}
template <int N> __device__ __forceinline__ void wave_sum_n(float (&x)[N]) {
#pragma unroll
    for (int i = 0; i < N; ++i) WS_DPP_ADD(x[i], 0x111, 0xf);
#pragma unroll
    for (int i = 0; i < N; ++i) WS_DPP_ADD(x[i], 0x112, 0xf);
#pragma unroll
    for (int i = 0; i < N; ++i) WS_DPP_ADD(x[i], 0x114, 0xf);
#pragma unroll
    for (int i = 0; i < N; ++i) WS_DPP_ADD(x[i], 0x118, 0xf);
#pragma unroll
    for (int i = 0; i < N; ++i) WS_DPP_ADD(x[i], 0x142, 0xa);
#pragma unroll
    for (int i = 0; i < N; ++i) WS_DPP_ADD(x[i], 0x143, 0xc);
#pragma unroll
    for (int i = 0; i < N; ++i) x[i] = __int_as_float(__builtin_amdgcn_readlane(__float_as_int(x[i]), 63));
}
__device__ __forceinline__ float sigmoidf_(float x) { return __builtin_amdgcn_rcpf(1.f + __builtin_amdgcn_exp2f(-1.4426950408889634f * x)); }

struct Args { const float* in[18]; float* out; unsigned char* ws; };

template <int MAPMODE> __device__ __forceinline__ void p0_transpose_item(const float* W, int K, int N, bf16_t* WT, const float* kscale, LAS float* scr, int item, int lane) {
    const int nblk = N / 32, kb = item / nblk, nb = item % nblk, k0 = 64 * kb, n0 = 32 * nb;
    const int orow0 = MAPMODE == 1 ? (((n0 % DFF) >> 7) * 256 + (n0 >= DFF ? 128 : 0) + ((n0 % DFF) & 127))
                    : (MAPMODE == 2 && n0 < 1024) ? ((n0 & ~255) + 128 * ((n0 >> 5) & 1) + 32 * ((n0 & 255) >> 6))
                    : (MAPMODE == 2 && n0 >= 1536 && n0 < 2560) ? ((6 + (((n0 - 1536) & 511) >> 7)) * 256 + (n0 >= 2048 ? 128 : 0) + (n0 & 127)) : n0;
#pragma unroll
    for (int i = 0; i < 8; ++i) { const int kk = 8 * i + (lane >> 3), cc = 4 * (lane & 7);
        f32x4 v = *(const f32x4*)(W + (size_t)(k0 + kk) * N + n0 + cc); if (kscale) v = v * kscale[k0 + kk];
        LAS float* d = scr + kk * 33 + cc; d[0] = v[0]; d[1] = v[1]; d[2] = v[2]; d[3] = v[3]; }
    asm volatile("s_waitcnt lgkmcnt(0)" ::: "memory");
    const int c = lane & 7;
#pragma unroll
    for (int j = 0; j < 4; ++j) { const int n = (lane >> 3) + 8 * j; const LAS float* s = scr + (8 * c) * 33 + n;
        u32x4 o; o.x = pk2(s[0 * 33], s[1 * 33]); o.y = pk2(s[2 * 33], s[3 * 33]); o.z = pk2(s[4 * 33], s[5 * 33]); o.w = pk2(s[6 * 33], s[7 * 33]);
        *(u32x4*)(WT + (size_t)(orow0 + n) * K + k0 + 8 * c) = o; }
    asm volatile("s_waitcnt lgkmcnt(0)" ::: "memory");
}


#define XB_TMO      128
#define XB_XCNT(j)  (256  + 64 * (j))
#define XB_XSUB(j)  (1280 + 64 * (j))
#define XB_XGEN(j)  (2304 + 64 * (j))
#define XB_TOP      3328
#define XB_TOPGEN   3392
#define XCD_BAR_WORDS 3456
#define XB_SPIN_CAP (1u << 18)
__device__ __forceinline__ unsigned xb_ld(unsigned* p)              { return __hip_atomic_load(p, __ATOMIC_RELAXED, __HIP_MEMORY_SCOPE_AGENT); }
__device__ __forceinline__ unsigned xb_add(unsigned* p, unsigned v) { return __hip_atomic_fetch_add(p, v, __ATOMIC_RELAXED, __HIP_MEMORY_SCOPE_AGENT); }
__device__ __forceinline__ unsigned xb_xcc_id() { return (unsigned)__builtin_amdgcn_s_getreg((3 << 11) | 20) & 0xFu; }
#define XB_SPIN(cond, bar) do { unsigned _sp = 0; while (cond) { __builtin_amdgcn_s_sleep(1); \
    if ((++_sp & 255u) == 0u) { if (xb_ld(&(bar)[XB_TMO])) break; if (_sp > XB_SPIN_CAP) { atomicAdd(&(bar)[XB_TMO], 1u); break; } } } } while (0)
struct XcdBarrier { unsigned* bar; unsigned x; volatile LAS unsigned* st; };
__device__ __forceinline__ XcdBarrier xcd_barrier_post(unsigned* bar, volatile LAS unsigned* st) {
    XcdBarrier b; b.bar = bar; b.x = xb_xcc_id(); b.st = st;
    if (threadIdx.x == 0) (void)xb_add(&bar[XB_XCNT(b.x)], 1u);
    return b;
}
__device__ __forceinline__ void xcd_barrier_complete(unsigned* bar, unsigned x, unsigned& nloc, unsigned& nx) {
    const unsigned G = gridDim.x * gridDim.y * gridDim.z;
    unsigned sum, cnt, mine, sp = 0u;
    for (;;) {
        sum = 0u; cnt = 0u; mine = 0u;
#pragma unroll
        for (unsigned j = 0; j < 16; ++j) { const unsigned c = xb_ld(&bar[XB_XCNT(j)]); sum += c; cnt += (c > 0u) ? 1u : 0u; mine = (j == x) ? c : mine; }
        if (sum == G) break;
        __builtin_amdgcn_s_sleep(1);
        if ((++sp & 255u) == 0u) { if (xb_ld(&bar[XB_TMO])) break; if (sp > XB_SPIN_CAP) { atomicAdd(&bar[XB_TMO], 1u); break; } }
    }
    nloc = mine > 0u ? mine : 1u; nx = cnt > 0u ? cnt : 1u;
}
__device__ __forceinline__ void xcd_barrier(const XcdBarrier& b) {
    asm volatile("s_waitcnt vmcnt(0)" ::: "memory");
    __syncthreads();
    if (threadIdx.x == 0) {
        unsigned* bar = b.bar;
        __builtin_amdgcn_s_waitcnt(0);
        unsigned nloc = b.st[0], nx = b.st[1];
        if (nloc == 0u) { xcd_barrier_complete(bar, b.x, nloc, nx); b.st[0] = nloc; b.st[1] = nx; }
        const unsigned old = xb_add(&bar[XB_XSUB(b.x)], 1u);
        const unsigned gen = old / nloc;
        if (old + 1u == (gen + 1u) * nloc) {
            __builtin_amdgcn_fence(__ATOMIC_RELEASE, "agent");
            asm volatile("s_waitcnt vmcnt(0)" ::: "memory");
            const unsigned og = xb_add(&bar[XB_TOP], 1u);
            const unsigned tg = og / nx;
            if (og + 1u == (tg + 1u) * nx) xb_add(&bar[XB_TOPGEN], 1u);
            else XB_SPIN(xb_ld(&bar[XB_TOPGEN]) == tg, bar);
            __builtin_amdgcn_fence(__ATOMIC_ACQUIRE, "agent");
            xb_add(&bar[XB_XGEN(b.x)], 1u);
            asm volatile("s_waitcnt vmcnt(0)" ::: "memory");
        } else {
            XB_SPIN(xb_ld(&bar[XB_XGEN(b.x)]) == gen, bar);
            __builtin_amdgcn_fence(__ATOMIC_ACQUIRE, "agent");
            asm volatile("s_waitcnt vmcnt(0)" ::: "memory");
        }
    }
    __syncthreads();
}
constexpr int CW_BAR = 4096;
constexpr int LDS_MISC = 147456 - 64;

typedef short bf16x8_t __attribute__((ext_vector_type(8)));
typedef short s16x4_t __attribute__((ext_vector_type(4)));
typedef float f32x16 __attribute__((ext_vector_type(16)));
typedef float f32x2_t __attribute__((ext_vector_type(2)));
typedef __bf16 bf16x2_t __attribute__((ext_vector_type(2)));
__device__ __forceinline__ unsigned cvtpk(float lo, float hi) { f32x2_t v = {lo, hi}; bf16x2_t b = __builtin_convertvector(v, bf16x2_t); return __builtin_bit_cast(unsigned, b); }
__device__ __forceinline__ bf16x8_t ld_row8(const LAS unsigned char* p) { return *(const LAS bf16x8_t*)p; }
__device__ __forceinline__ bf16x8_t ld_tr2(const LAS unsigned char* plo, const LAS unsigned char* phi) {
    const s16x4_t lo = __builtin_bit_cast(s16x4_t, __builtin_amdgcn_ds_read_tr16_b64_v4i16((LAS s16x4_t*)plo));
    const s16x4_t hi = __builtin_bit_cast(s16x4_t, __builtin_amdgcn_ds_read_tr16_b64_v4i16((LAS s16x4_t*)phi));
    return (bf16x8_t){lo[0], lo[1], lo[2], lo[3], hi[0], hi[1], hi[2], hi[3]};
}
__device__ __forceinline__ int crow(int r, int h) { return (r & 3) + 8 * (r >> 2) + 4 * h; }
constexpr float LOG2E = 1.4426950408889634f;
constexpr float QSCALE = 0.125f * LOG2E;

namespace fa {
constexpr int SLOT = 32768, NSLOT = 4, KB_ = 0, VB_ = 16384;
constexpr int RB0 = 2 * SLOT, RSRB = 272, RTB = 128 * RSRB;
constexpr int OFF_WL = RB0 + 2 * RTB;
constexpr int OFF_Q = OFF_WL + 1024;
static_assert(OFF_WL >= NSLOT * SLOT && OFF_Q + 16 + 512 <= LDS_MISC, "attention LDS map");
#define FA_SB() __builtin_amdgcn_sched_barrier(0)

__device__ __forceinline__ int attn_run(LAS unsigned char* lds, const bf16_t* __restrict__ PROJ, bf16_t* __restrict__ MIX, const float* __restrict__ sublnw, unsigned* ctl,
                                        float lam, int tid, int lane, int wave) {
    const int r32 = lane & 31, hi = lane >> 5, rb = wave & 3, c = wave >> 2;
    LAS int* qslot = (LAS int*)(lds + OFF_Q);
    LAS float* swl = (LAS float*)(lds + OFF_Q + 16);
    if (tid < 128) swl[tid] = sublnw[tid];
    int kof[4], vof[4];
    const int g4 = lane >> 4, i16 = lane & 15, q4 = i16 >> 2, p4 = i16 & 3;
#pragma unroll
    for (int d0 = 0; d0 < 4; ++d0) kof[d0] = KB_ + r32 * 256 + (((c * 8 + 2 * d0 + hi) ^ (r32 & 15)) << 4);
#pragma unroll
    for (int eb = 0; eb < 4; ++eb) vof[eb] = VB_ + (4 * hi + q4) * 256 + ((4 * (eb ^ q4) + 2 * (g4 & 1) + (p4 >> 1)) << 4) + 8 * (p4 & 1);
    size_t goff[4];
#pragma unroll
    for (int i = 0; i < 2; ++i) {
        const int row = 8 * wave + 4 * i + (lane >> 4), pc = lane & 15;
        goff[i]     = (size_t)row * NCOLS + OFF_DK + ((pc ^ (row & 15)) << 3);
        goff[2 + i] = (size_t)row * NCOLS + OFF_DV + ((pc ^ ((row & 3) << 2)) << 3);
    }
#define FA_DMA(gbase, t, slot) do { const bf16_t* g_ = (gbase) + (size_t)(t) * 64 * NCOLS; LAS unsigned char* d_ = lds + (slot) * SLOT + wave * 2048; \
        __builtin_amdgcn_global_load_lds((const unsigned*)(g_ + goff[0]), (LAS unsigned*)(d_ + KB_), 16, 0, 0); \
        __builtin_amdgcn_global_load_lds((const unsigned*)(g_ + goff[1]), (LAS unsigned*)(d_ + KB_ + 1024), 16, 0, 0); \
        __builtin_amdgcn_global_load_lds((const unsigned*)(g_ + goff[2]), (LAS unsigned*)(d_ + VB_), 16, 0, 0); \
        __builtin_amdgcn_global_load_lds((const unsigned*)(g_ + goff[3]), (LAS unsigned*)(d_ + VB_ + 1024), 16, 0, 0); } while (0)
#define FA_DMA1(gbase, t, slot, i) __builtin_amdgcn_global_load_lds((const unsigned*)((gbase) + (size_t)(t) * 64 * NCOLS + goff[i]), \
        (LAS unsigned*)(lds + (slot) * SLOT + wave * 2048 + ((i) >> 1) * VB_ + ((i) & 1) * 1024), 16, 0, 0)
#define FA_PREFETCH(uu) do { const int b_ = ((uu) & 63) >> 2, h_ = (uu) & 3, qb_ = 15 - ((uu) >> 6); \
        const bf16_t* qp_ = PROJ + ((size_t)b_ * S + qb_ * 128 + rb * 32 + r32) * NCOLS + OFF_DQ + h_ * 128 + c * 64 + hi * 8; \
        _Pragma("unroll") for (int d0 = 0; d0 < 4; ++d0) asm volatile("global_load_dwordx4 %0, %1, off" : "=v"(qr[d0]) : "v"(qp_ + d0 * 16) : "memory"); \
        const bf16_t* gb_ = PROJ + (size_t)b_ * S * NCOLS + h_ * 128; FA_DMA(gb_, 0, 0); FA_DMA(gb_, 1, 1); } while (0)
    if (tid == 0) *qslot = (int)__hip_atomic_fetch_add(ctl, 1u, __ATOMIC_RELAXED, __HIP_MEMORY_SCOPE_AGENT);
    __syncthreads();
    int u = __builtin_amdgcn_readfirstlane(*qslot);
    __syncthreads();
    if (u >= 1024) return u;
    bf16x8_t qr[4];
#define FA_POP() do { if (tid == 0) { const unsigned one_ = 1u; asm volatile("global_atomic_add %0, %1, %2, off sc0" : "=v"(popped) : "v"(ctl), "v"(one_) : "memory"); } } while (0)
    int popped = 0;
    FA_POP();
    FA_PREFETCH(u);
    { unsigned* dst_ = ctl + 131072 + blockIdx.x * NTHREADS + tid;
#pragma unroll
      for (int i = 0; i < 4; ++i) asm volatile("global_store_dword %0, %1, off" :: "v"(dst_), "v"(lane) : "memory"); }
    for (;;) {
        const int b = (u & 63) >> 2, h = u & 3, qb = 15 - (u >> 6);
        const size_t rowbase = (size_t)b * S;
        const bf16_t* gbase = PROJ + rowbase * NCOLS + h * 128;
        const int NT = 2 * qb + 2, cw = 2 * qb + (rb >> 1);
        f32x16 o[4];
#pragma unroll
        for (int e = 0; e < 4; ++e)
#pragma unroll
            for (int r = 0; r < 16; ++r) o[e][r] = 0.f;
        float lsum = 0.f;
        f32x16 C[2];
        const f32x16 fzero = {0.f, 0.f, 0.f, 0.f, 0.f, 0.f, 0.f, 0.f, 0.f, 0.f, 0.f, 0.f, 0.f, 0.f, 0.f, 0.f};
        unsigned pw[16], pwn[16];
#pragma unroll
        for (int i = 0; i < 16; ++i) { pw[i] = 0u; pwn[i] = 0u; }
#define FA_VFRAG(slB, j) ld_tr2((slB) + vof[(j) & 3] + (((j) >> 2) * 16) * 256, (slB) + vof[(j) & 3] + (((j) >> 2) * 16 + 8) * 256)
#define FA_PW(ks) __builtin_bit_cast(bf16x8_t, (u32x4){pw[4 * (ks)], pw[4 * (ks) + 1], pw[4 * (ks) + 2], pw[4 * (ks) + 3]})
#define FA_STEP(DO_A, DO_B, slA, slB, masked, dma_on, dma_t, dma_slot) do { \
            bf16x8_t vf[16]; bf16x8_t ka[4], kb2[4]; \
            if (DO_A) { ka[0] = ld_row8((slA) + kof[0]); kb2[0] = ld_row8((slA) + kof[0] + 8192); \
                        ka[1] = ld_row8((slA) + kof[1]); kb2[1] = ld_row8((slA) + kof[1] + 8192); \
                if (masked) { _Pragma("unroll") for (int r = 0; r < 16; ++r) { C[0][r] = -1.0e30f; C[1][r] = -1.0e30f; } \
                    C[0] = __builtin_amdgcn_mfma_f32_32x32x16_bf16(ka[0], qr[0], C[0], 0, 0, 0); FA_SB(); C[1] = __builtin_amdgcn_mfma_f32_32x32x16_bf16(kb2[0], qr[0], C[1], 0, 0, 0); FA_SB(); } \
                else { C[0] = __builtin_amdgcn_mfma_f32_32x32x16_bf16(ka[0], qr[0], fzero, 0, 0, 0); FA_SB(); C[1] = __builtin_amdgcn_mfma_f32_32x32x16_bf16(kb2[0], qr[0], fzero, 0, 0, 0); FA_SB(); } } \
            _Pragma("unroll") for (int d0 = 1; d0 < 4; ++d0) { \
                if (DO_A && d0 < 3) { ka[d0 + 1] = ld_row8((slA) + kof[d0 + 1]); kb2[d0 + 1] = ld_row8((slA) + kof[d0 + 1] + 8192); } \
                if (DO_A) C[0] = __builtin_amdgcn_mfma_f32_32x32x16_bf16(ka[d0], qr[d0], C[0], 0, 0, 0); \
                if (DO_B && 2 * d0 >= 4) vf[2 * d0 - 4] = FA_VFRAG(slB, 2 * d0 - 4); \
                FA_SB(); \
                if (DO_A) C[1] = __builtin_amdgcn_mfma_f32_32x32x16_bf16(kb2[d0], qr[d0], C[1], 0, 0, 0); \
                if (DO_B && 2 * d0 + 1 >= 4) vf[2 * d0 - 3] = FA_VFRAG(slB, 2 * d0 - 3); \
                if (DO_A) { if (dma_on) { FA_DMA1(gbase, dma_t, dma_slot, d0); if (d0 == 1) FA_DMA1(gbase, dma_t, dma_slot, 0); } } \
                FA_SB(); } \
            if (DO_B && !(DO_A)) { _Pragma("unroll") for (int j = 0; j < 4; ++j) vf[j] = FA_VFRAG(slB, j); } \
            _Pragma("unroll") for (int j = 0; j < 16; ++j) { \
                if (DO_B) o[j & 3] = __builtin_amdgcn_mfma_f32_32x32x16_bf16(FA_PW(j >> 2), vf[j], o[j & 3], 0, 0, 0); \
                if (DO_B && j + 4 < 16) vf[j + 4] = FA_VFRAG(slB, j + 4); \
                if (DO_A) { C[(2 * j) >> 4][(2 * j) & 15] = __builtin_amdgcn_exp2f(C[(2 * j) >> 4][(2 * j) & 15]); C[(2 * j + 1) >> 4][(2 * j + 1) & 15] = __builtin_amdgcn_exp2f(C[(2 * j + 1) >> 4][(2 * j + 1) & 15]); \
                    if (j >= 1) { const float a_ = C[(2 * j - 2) >> 4][(2 * j - 2) & 15], b_ = C[(2 * j - 1) >> 4][(2 * j - 1) & 15]; pwn[j - 1] = cvtpk(a_, b_); lsum += a_; lsum += b_; } } \
                FA_SB(); } \
            if (DO_A) { const float a_ = C[1][14], b_ = C[1][15]; pwn[15] = cvtpk(a_, b_); lsum += a_; lsum += b_; } \
            _Pragma("unroll") for (int i = 0; i < 16; ++i) pw[i] = pwn[i]; \
            FA_SB(); } while (0)
        asm volatile("s_waitcnt vmcnt(8)" : "+v"(qr[0]), "+v"(qr[1]), "+v"(qr[2]), "+v"(qr[3]), "+v"(popped) :: "memory");
        if (tid == 0) *qslot = popped;
        asm volatile("s_waitcnt lgkmcnt(0)" ::: "memory"); __builtin_amdgcn_s_barrier(); asm volatile("" ::: "memory");
        FA_STEP(true, false, lds, lds, false, 2 < NT, 2, 2);
        int slot = 1;
        for (int t = 1; t < NT; ++t) {
            if (t + 1 < NT) asm volatile("s_waitcnt vmcnt(4)" ::: "memory"); else asm volatile("s_waitcnt vmcnt(0)" ::: "memory");
            asm volatile("s_waitcnt lgkmcnt(0)" ::: "memory"); __builtin_amdgcn_s_barrier(); asm volatile("" ::: "memory");
            const LAS unsigned char* slA = lds + slot * SLOT; const LAS unsigned char* slB = lds + ((slot + 3) & 3) * SLOT;
            FA_STEP(true, true, slA, slB, t > cw, t + 2 < NT, t + 2, (slot + 2) & 3);
            slot = (slot + 1) & 3;
        }
        { const LAS unsigned char* slB = lds + ((slot + 3) & 3) * SLOT; FA_STEP(false, true, slB, slB, false, false, 0, 0); }
        asm volatile("s_waitcnt lgkmcnt(0)" ::: "memory"); __builtin_amdgcn_s_barrier(); asm volatile("" ::: "memory");
        const int un = __builtin_amdgcn_readfirstlane(*qslot);
        if (un < 1024) { FA_POP(); FA_PREFETCH(un); }
        lsum += __shfl_xor(lsum, 32);
        LAS float* wl = (LAS float*)(lds + OFF_WL) + wave * 32;
        if (hi == 0) wl[r32] = lsum;
        asm volatile("s_waitcnt lgkmcnt(0)" ::: "memory");
        {
            LAS unsigned char* R = lds + RB0 + c * RTB + (rb * 32) * RSRB + r32 * 2;
#pragma unroll
            for (int r = 0; r < 16; ++r) {
                const float rl = (c ? lam : 1.f) * __builtin_amdgcn_rcpf(wl[crow(r, hi)]);
#pragma unroll
                for (int eb = 0; eb < 4; ++eb) *(LAS unsigned short*)(R + crow(r, hi) * RSRB + eb * 64) = (unsigned short)cvtpk(o[eb][r] * rl, 0.f);
            }
        }
        asm volatile("s_waitcnt lgkmcnt(0)" ::: "memory"); __builtin_amdgcn_s_barrier(); asm volatile("" ::: "memory");
        for (int it = 0; it < 2; ++it) {
            const int row = wave * 16 + it * 8 + (lane >> 3), sg = lane & 7;
            const LAS unsigned char* rp = lds + RB0 + row * RSRB + sg * 32;
            const u32x4 a0 = *(const LAS u32x4*)rp, a1 = *(const LAS u32x4*)(rp + 16), b0 = *(const LAS u32x4*)(rp + RTB), b1 = *(const LAS u32x4*)(rp + RTB + 16);
            const f32x4 w0 = *(const LAS f32x4*)(swl + sg * 16), w1 = *(const LAS f32x4*)(swl + sg * 16 + 4), w2 = *(const LAS f32x4*)(swl + sg * 16 + 8), w3 = *(const LAS f32x4*)(swl + sg * 16 + 12);
            float dv[16];
#pragma unroll
            for (int i = 0; i < 4; ++i) {
                dv[2 * i]     = __uint_as_float(a0[i] << 16) - __uint_as_float(b0[i] << 16);         dv[2 * i + 1] = __uint_as_float(a0[i] & 0xffff0000u) - __uint_as_float(b0[i] & 0xffff0000u);
                dv[8 + 2 * i] = __uint_as_float(a1[i] << 16) - __uint_as_float(b1[i] << 16);     dv[8 + 2 * i + 1] = __uint_as_float(a1[i] & 0xffff0000u) - __uint_as_float(b1[i] & 0xffff0000u);
            }
            float ss = 0.f;
#pragma unroll
            for (int i = 0; i < 16; i += 4) ss += (dv[i] * dv[i] + dv[i + 1] * dv[i + 1]) + (dv[i + 2] * dv[i + 2] + dv[i + 3] * dv[i + 3]);
            ss += __int_as_float(__builtin_amdgcn_update_dpp(0, __float_as_int(ss), 0xB1, 0xf, 0xf, true));
            ss += __int_as_float(__builtin_amdgcn_update_dpp(0, __float_as_int(ss), 0x4E, 0xf, 0xf, true));
            ss += __int_as_float(__builtin_amdgcn_update_dpp(0, __float_as_int(ss), 0x141, 0xf, 0xf, true));
            const float rr = rsqrtf(ss * (1.f / 128.f) + EPS) * (1.f - LAM_INIT);
            u32x4 o0, o1;
#pragma unroll
            for (int i = 0; i < 2; ++i) {
                o0[i]     = cvtpk(dv[2 * i] * rr * w0[2 * i], dv[2 * i + 1] * rr * w0[2 * i + 1]);
                o0[2 + i] = cvtpk(dv[4 + 2 * i] * rr * w1[2 * i], dv[4 + 2 * i + 1] * rr * w1[2 * i + 1]);
                o1[i]     = cvtpk(dv[8 + 2 * i] * rr * w2[2 * i], dv[8 + 2 * i + 1] * rr * w2[2 * i + 1]);
                o1[2 + i] = cvtpk(dv[12 + 2 * i] * rr * w3[2 * i], dv[12 + 2 * i + 1] * rr * w3[2 * i + 1]);
            }
            bf16_t* op = MIX + (rowbase + qb * 128 + row) * D + h * 128 + sg * 16;
            asm volatile("global_store_dwordx4 %0, %1, off\n\ts_nop 1" :: "v"(op), "v"(o0) : "memory");
            asm volatile("global_store_dwordx4 %0, %1, off\n\ts_nop 1" :: "v"(op + 8), "v"(o1) : "memory");
        }
        if (un >= 1024) {
            asm volatile("s_waitcnt lgkmcnt(0)" ::: "memory"); __builtin_amdgcn_s_barrier(); asm volatile("" ::: "memory");
            return un;
        }
        u = un;
    }
#undef FA_STEP
#undef FA_PW
#undef FA_VFRAG
#undef FA_DMA
#undef FA_DMA1
#undef FA_PREFETCH
#undef FA_POP
}
#undef FA_SB
}


namespace hg {
constexpr int RSQ = 272, RSKR = 272, RSKC = 320, RSV = 320, RSA = 144, RSS = 272, RSR = 132;
constexpr int OFF_QT = 0;
constexpr int OFF_KR = OFF_QT + 64 * RSQ;
constexpr int OFF_KC = OFF_KR + 64 * RSKR;
constexpr int OFF_VT = OFF_KC + 64 * RSKC;
constexpr int OFF_AM = OFF_VT + 64 * RSV;
constexpr int OFF_ST = OFF_AM + 64 * RSA;
constexpr int OFF_BL = OFF_ST + 128 * RSS;
constexpr int OFF_GT = OFF_BL + 512;
constexpr int OFF_R = OFF_KR;
static_assert(OFF_GT + 64 * 256 <= LDS_MISC && 64 * RSR * 4 <= 64 * RSKR + 64 * RSKC, "hgrn LDS map");


#define HG_DPP_ADD(x, ctrl) x += __int_as_float(__builtin_amdgcn_update_dpp(0, __float_as_int(x), ctrl, 0xf, 0xf, true))
__device__ __forceinline__ void hgrn_pre_wave(bf16_t* PROJ, const float* __restrict__ lbl, float* __restrict__ DL, int b0, int h, int ch, int c4, int lane) {
    const int tr = lane & 15, cc = lane >> 4, col = h * 128 + 32 * c4 + 8 * cc;
    float lbv[8];
#pragma unroll
    for (int j = 0; j < 8; ++j) { const float l0 = lbl[col + j], l1 = lbl[512 + col + j]; lbv[j] = __builtin_amdgcn_rcpf(1.f + __builtin_amdgcn_exp2f((l1 - l0) * 1.4426950408889634f)); }
    bf16_t* gq = PROJ + ((size_t)b0 * S + ch * 64 + 4 * tr) * NCOLS + OFF_HQ + col;
    bf16_t* gf = PROJ + ((size_t)b0 * S + ch * 64 + 4 * tr) * NCOLS + OFF_HF + col;
    u32x4 nq[4], nf[4];
#pragma unroll
    for (int m = 0; m < 4; ++m) { nq[m] = *(const u32x4*)(gq + m * NCOLS); nf[m] = *(const u32x4*)(gf + m * NCOLS); }
    for (int k = 0; k < NB / 4; ++k) {
        u32x4 wq[4], wf[4];
#pragma unroll
        for (int m = 0; m < 4; ++m) { wq[m] = nq[m]; wf[m] = nf[m]; }
        bf16_t* cq = gq; bf16_t* cf = gf;
        if (k + 1 < NB / 4) { gq += (size_t)4 * S * NCOLS; gf += (size_t)4 * S * NCOLS;
#pragma unroll
            for (int m = 0; m < 4; ++m) { nq[m] = *(const u32x4*)(gq + m * NCOLS); nf[m] = *(const u32x4*)(gf + m * NCOLS); } }
        float bc[4][8], omf[4][8];
#pragma unroll
        for (int m = 0; m < 4; ++m)
#pragma unroll
            for (int j = 0; j < 8; ++j) {
                const unsigned w = wf[m][j >> 1];
                const float z = bf2f((j & 1) ? (w >> 16) : (w & 0xffffu));
                const float f = lbv[j] + (1.f - lbv[j]) * sigmoidf_(z);
                omf[m][j] = 1.f - f; bc[m][j] = __builtin_amdgcn_logf(f) + (m ? bc[m - 1][j] : 0.f);
            }
#pragma unroll
        for (int j = 0; j < 8; ++j) {
            float tot = bc[3][j];
            HG_DPP_ADD(tot, 0x111); HG_DPP_ADD(tot, 0x112); HG_DPP_ADD(tot, 0x114); HG_DPP_ADD(tot, 0x118);
            const float carry = tot - bc[3][j];
#pragma unroll
            for (int m = 0; m < 4; ++m) bc[m][j] += carry;
        }
#pragma unroll
        for (int m = 0; m < 4; ++m) {
            unsigned oq[4], ok[4];
#pragma unroll
            for (int i = 0; i < 4; ++i) {
                const float q0 = bf2f(wq[m][i] & 0xffffu), q1 = bf2f(wq[m][i] >> 16);
                const float e0 = __builtin_amdgcn_exp2f(bc[m][2 * i]), e1 = __builtin_amdgcn_exp2f(bc[m][2 * i + 1]), n0 = __builtin_amdgcn_exp2f(-bc[m][2 * i]), n1 = __builtin_amdgcn_exp2f(-bc[m][2 * i + 1]);
                oq[i] = cvtpk(q0 * e0, q1 * e1); ok[i] = cvtpk(omf[m][2 * i] * n0, omf[m][2 * i + 1] * n1);
            }
            *(u32x4*)(cq + m * NCOLS) = (u32x4){oq[0], oq[1], oq[2], oq[3]};
            *(u32x4*)(cf + m * NCOLS) = (u32x4){ok[0], ok[1], ok[2], ok[3]};
        }
        if (tr == 15) {
            float* dp = DL + (size_t)(((b0 + 4 * k) * 4 + h) * 32 + ch) * 128 + 32 * c4 + 8 * cc;
            *(f32x4*)dp = (f32x4){__builtin_amdgcn_exp2f(bc[3][0]), __builtin_amdgcn_exp2f(bc[3][1]), __builtin_amdgcn_exp2f(bc[3][2]), __builtin_amdgcn_exp2f(bc[3][3])};
            *(f32x4*)(dp + 4) = (f32x4){__builtin_amdgcn_exp2f(bc[3][4]), __builtin_amdgcn_exp2f(bc[3][5]), __builtin_amdgcn_exp2f(bc[3][6]), __builtin_amdgcn_exp2f(bc[3][7])};
        }
    }
}
#undef HG_DPP_ADD

__device__ __forceinline__ void hgrn_unit(LAS unsigned char* lds, const bf16_t* __restrict__ PROJ, bf16_t* __restrict__ MIX, const float* __restrict__ DL, const float* __restrict__ hnw,
                                          int b, int h, int tid, int lane, int wave) {
    const int r32 = lane & 31, hi = lane >> 5, g4 = lane >> 4, i16 = lane & 15;
    const size_t rowbase = (size_t)b * S;
    f32x16 sreg[2];
#pragma unroll
    for (int j = 0; j < 2; ++j)
#pragma unroll
        for (int r = 0; r < 16; ++r) sreg[j][r] = 0.f;
    for (int i = tid; i < 128 * RSS / 16; i += NTHREADS) *(LAS u32x4*)(lds + OFF_ST + i * 16) = (u32x4){0u, 0u, 0u, 0u};
    const int vb = wave & 3, kb0 = 2 * (wave >> 2), tb = wave >> 2;
    const int trb = (8 * hi + (i16 >> 2)) * 320 + (16 * (g4 & 1) + 4 * (i16 & 3)) * 2;
    const int rrb = r32 * 272 + hi * 16;
    const int half = wave >> 2, st = tid & 255, srow = st >> 4, sch = st & 15;
    const bf16_t* gq = PROJ + (rowbase + srow) * NCOLS + OFF_HQ + h * 128 + sch * 8;
    const bf16_t* gf = PROJ + (rowbase + srow) * NCOLS + OFF_HF + h * 128 + sch * 8;
    const bf16_t* gi = PROJ + (rowbase + srow) * NCOLS + OFF_HI + h * 128 + sch * 8;
    const bf16_t* gg = PROJ + (rowbase + srow) * NCOLS + OFF_HG + h * 128 + sch * 8;
    const float* gd = DL + (size_t)((b * 4 + h) * 32) * 128 + (st & 31) * 4;
    u32x4 nq[4], nf[4], nv[4], ng[4]; f32x4 nd = (f32x4){0.f, 0.f, 0.f, 0.f};
#define HG_LD16(dst, ptr) asm volatile("global_load_dwordx4 %0, %1, off" : "=v"(dst) : "v"(ptr) : "memory")
#define HG_LOAD(chn) do { const size_t o_ = (size_t)(chn) * 64 * NCOLS; \
        _Pragma("unroll") for (int i = 0; i < 4; ++i) { HG_LD16(nq[i], gq + o_ + i * 16 * NCOLS); HG_LD16(nf[i], gf + o_ + i * 16 * NCOLS); HG_LD16(nv[i], gi + o_ + i * 16 * NCOLS); HG_LD16(ng[i], gg + o_ + i * 16 * NCOLS); } \
        HG_LD16(nd, gd + (chn) * 128); } while (0)
#define HG_TIES "+v"(nq[0]), "+v"(nq[1]), "+v"(nq[2]), "+v"(nq[3]), "+v"(nf[0]), "+v"(nf[1]), "+v"(nf[2]), "+v"(nf[3]), "+v"(nv[0]), "+v"(nv[1]), "+v"(nv[2]), "+v"(nv[3]), \
                "+v"(ng[0]), "+v"(ng[1]), "+v"(ng[2]), "+v"(ng[3]), "+v"(nd)
    HG_LOAD(half);
    {
        const u32x4 zero_ = (u32x4){0u, 0u, 0u, 0u};
        bf16_t* op = MIX + (rowbase + wave * 8 + (lane >> 3)) * D + 512 + h * 128 + (lane & 7) * 16;
        asm volatile("global_store_dwordx4 %0, %1, off\n\ts_nop 1" :: "v"(op), "v"(zero_) : "memory");
        asm volatile("global_store_dwordx4 %0, %1, off\n\ts_nop 1" :: "v"(op + 8), "v"(zero_) : "memory");
        if (half == 0) {
            asm volatile("global_store_dwordx4 %0, %1, off\n\ts_nop 1" :: "v"(op), "v"(zero_) : "memory");
            asm volatile("global_store_dwordx4 %0, %1, off\n\ts_nop 1" :: "v"(op + 8), "v"(zero_) : "memory");
        }
    }
    for (int ch = 0; ch < S / 64; ++ch) {
        if (half == (ch & 1)) {
            asm volatile("s_waitcnt vmcnt(4)" : HG_TIES :: "memory");
#pragma unroll
            for (int i = 0; i < 4; ++i) {
                *(LAS u32x4*)(lds + OFF_QT + (srow + 16 * i) * RSQ + sch * 16) = nq[i];
                *(LAS u32x4*)(lds + OFF_KR + (srow + 16 * i) * RSKR + sch * 16) = nf[i];
                *(LAS u32x4*)(lds + OFF_KC + (srow + 16 * i) * RSKC + sch * 16) = nf[i];
                *(LAS u32x4*)(lds + OFF_VT + (srow + 16 * i) * RSV + sch * 16) = nv[i];
                *(LAS u32x4*)(lds + OFF_GT + (srow + 16 * i) * 256 + sch * 16) = ng[i];
            }
            if (st < 32) *(LAS f32x4*)(lds + OFF_BL + st * 16) = nd;
            if (ch + 2 < S / 64) HG_LOAD(ch + 2);
        }
        __syncthreads();
        {
            const LAS unsigned char* ka = lds + OFF_KC + trb + kb0 * 64;
            const LAS unsigned char* va = lds + OFF_VT + trb + vb * 64;
            bf16x8_t wb[4], wa0[4], wa1[4];
#define HG_WLD(i) do { wb[i] = ld_tr2(va + (i) * 16 * 320, va + (i) * 16 * 320 + 4 * 320); wa0[i] = ld_tr2(ka + (i) * 16 * 320, ka + (i) * 16 * 320 + 4 * 320); \
                       wa1[i] = ld_tr2(ka + 64 + (i) * 16 * 320, ka + 64 + (i) * 16 * 320 + 4 * 320); } while (0)
#define HG_WMM(i) do { sreg[0] = __builtin_amdgcn_mfma_f32_32x32x16_bf16(wa0[i], wb[i], sreg[0], 0, 0, 0); sreg[1] = __builtin_amdgcn_mfma_f32_32x32x16_bf16(wa1[i], wb[i], sreg[1], 0, 0, 0); } while (0)
            HG_WLD(0); HG_WLD(1);
            if (wave < 3) {
                const int sb = wave >> 1, tbb = (wave + 1) >> 1;
                const LAS unsigned char* kr = lds + OFF_KR + rrb + sb * 32 * RSKR;
                const LAS unsigned char* qr_ = lds + OFF_QT + rrb + tbb * 32 * RSQ;
                bf16x8_t xk[8], xq[8];
                __builtin_amdgcn_sched_barrier(0);
                HG_WMM(0); HG_WLD(2);
#pragma unroll
                for (int k = 0; k < 2; ++k) { xk[k] = ld_row8(kr + k * 32); xq[k] = ld_row8(qr_ + k * 32); }
                __builtin_amdgcn_sched_barrier(0);
                HG_WMM(1); HG_WLD(3);
#pragma unroll
                for (int k = 2; k < 4; ++k) { xk[k] = ld_row8(kr + k * 32); xq[k] = ld_row8(qr_ + k * 32); }
                __builtin_amdgcn_sched_barrier(0);
                HG_WMM(2);
#pragma unroll
                for (int k = 4; k < 6; ++k) { xk[k] = ld_row8(kr + k * 32); xq[k] = ld_row8(qr_ + k * 32); }
                __builtin_amdgcn_sched_barrier(0);
                HG_WMM(3);
#pragma unroll
                for (int k = 6; k < 8; ++k) { xk[k] = ld_row8(kr + k * 32); xq[k] = ld_row8(qr_ + k * 32); }
                __builtin_amdgcn_sched_barrier(0);
                f32x16 acc;
#pragma unroll
                for (int r = 0; r < 16; ++r) acc[r] = 0.f;
#pragma unroll
                for (int k = 0; k < 8; ++k) acc = __builtin_amdgcn_mfma_f32_32x32x16_bf16(xk[k], xq[k], acc, 0, 0, 0);
                if (sb == tbb) {
#pragma unroll
                    for (int r = 0; r < 16; ++r) if (crow(r, hi) > r32) acc[r] = 0.f;
                }
                LAS unsigned char* am = lds + OFF_AM + (32 * tbb + r32) * RSA + (32 * sb + 4 * hi) * 2;
#pragma unroll
                for (int g = 0; g < 4; ++g) *(LAS u32x2*)(am + 16 * g) = (u32x2){cvtpk(acc[4 * g], acc[4 * g + 1]), cvtpk(acc[4 * g + 2], acc[4 * g + 3])};
            } else {
                __builtin_amdgcn_sched_barrier(0);
                HG_WMM(0); HG_WLD(2);
                __builtin_amdgcn_sched_barrier(0);
                HG_WMM(1); HG_WLD(3);
                __builtin_amdgcn_sched_barrier(0);
                HG_WMM(2); HG_WMM(3);
            }
#undef HG_WLD
#undef HG_WMM
            const LAS float* bl = (const LAS float*)(lds + OFF_BL);
#pragma unroll
            for (int j = 0; j < 2; ++j)
#pragma unroll
                for (int g = 0; g < 4; ++g) {
                    const f32x4 bv = *(const LAS f32x4*)(bl + 32 * (kb0 + j) + 8 * g + 4 * hi);
                    sreg[j][4 * g] *= bv[0]; sreg[j][4 * g + 1] *= bv[1]; sreg[j][4 * g + 2] *= bv[2]; sreg[j][4 * g + 3] *= bv[3];
                }
        }
        __syncthreads();
        {
            f32x16 acc;
#pragma unroll
            for (int r = 0; r < 16; ++r) acc[r] = 0.f;
            const LAS unsigned char* amr = lds + OFF_AM + (32 * tb + r32) * RSA + hi * 16;
            const LAS unsigned char* va = lds + OFF_VT + trb + vb * 64;
            const LAS unsigned char* qr_ = lds + OFF_QT + rrb + tb * 32 * RSQ;
            const LAS unsigned char* sr_ = lds + OFF_ST + rrb + vb * 32 * RSS;
            bf16x8_t ya[4], yv[4], yq[8], ys[8];
#pragma unroll
            for (int i = 0; i < 2; ++i) { ya[i] = ld_row8(amr + i * 32); yv[i] = ld_tr2(va + i * 16 * 320, va + i * 16 * 320 + 4 * 320); }
            if (tb) {
#pragma unroll
                for (int i = 2; i < 4; ++i) { ya[i] = ld_row8(amr + i * 32); yv[i] = ld_tr2(va + i * 16 * 320, va + i * 16 * 320 + 4 * 320); }
            }
#pragma unroll
            for (int k = 0; k < 4; ++k) { yq[k] = ld_row8(qr_ + k * 32); ys[k] = ld_row8(sr_ + k * 32); }
            __builtin_amdgcn_sched_barrier(0);
#pragma unroll
            for (int i = 0; i < 2; ++i) acc = __builtin_amdgcn_mfma_f32_32x32x16_bf16(ya[i], yv[i], acc, 0, 0, 0);
            if (tb) {
#pragma unroll
                for (int i = 2; i < 4; ++i) acc = __builtin_amdgcn_mfma_f32_32x32x16_bf16(ya[i], yv[i], acc, 0, 0, 0);
            }
#pragma unroll
            for (int k = 4; k < 8; ++k) { yq[k] = ld_row8(qr_ + k * 32); ys[k] = ld_row8(sr_ + k * 32); }
            __builtin_amdgcn_sched_barrier(0);
#pragma unroll
            for (int k = 0; k < 8; ++k) acc = __builtin_amdgcn_mfma_f32_32x32x16_bf16(yq[k], ys[k], acc, 0, 0, 0);
            LAS float* R = (LAS float*)(lds + OFF_R) + vb * 32 + r32;
#pragma unroll
            for (int r = 0; r < 16; ++r) R[(32 * tb + crow(r, hi)) * RSR] = acc[r];
        }
        __syncthreads();
        {
#pragma unroll
            for (int j = 0; j < 2; ++j) {
                LAS unsigned char* sp = lds + OFF_ST + (32 * vb + r32) * RSS + (32 * (kb0 + j) + 4 * hi) * 2;
#pragma unroll
                for (int g = 0; g < 4; ++g) *(LAS u32x2*)(sp + 16 * g) = (u32x2){cvtpk(sreg[j][4 * g], sreg[j][4 * g + 1]), cvtpk(sreg[j][4 * g + 2], sreg[j][4 * g + 3])};
            }
            {
                const int rw = lane >> 3, sg = lane & 7, t = wave * 8 + rw;
                const LAS float* rp = (const LAS float*)(lds + OFF_R) + t * RSR + sg * 16;
                const f32x4 r0 = *(const LAS f32x4*)rp, r1 = *(const LAS f32x4*)(rp + 4), r2 = *(const LAS f32x4*)(rp + 8), r3 = *(const LAS f32x4*)(rp + 12);
                const u32x4 g0 = *(const LAS u32x4*)(lds + OFF_GT + t * 256 + sg * 32), g1 = *(const LAS u32x4*)(lds + OFF_GT + t * 256 + sg * 32 + 16);
                float ss = 0.f;
#pragma unroll
                for (int i = 0; i < 4; ++i) ss += (r0[i] * r0[i] + r1[i] * r1[i]) + (r2[i] * r2[i] + r3[i] * r3[i]);
                ss += __int_as_float(__builtin_amdgcn_update_dpp(0, __float_as_int(ss), 0xB1, 0xf, 0xf, true));
                ss += __int_as_float(__builtin_amdgcn_update_dpp(0, __float_as_int(ss), 0x4E, 0xf, 0xf, true));
                ss += __int_as_float(__builtin_amdgcn_update_dpp(0, __float_as_int(ss), 0x141, 0xf, 0xf, true));
                const float rr = rsqrtf(ss * (1.f / 128.f) + EPS);
#define HG_PK(rv, gw, j) cvtpk(rv[2 * (j)] * rr * __uint_as_float(gw << 16), rv[2 * (j) + 1] * rr * __uint_as_float(gw & 0xffff0000u))
                const u32x4 o0 = (u32x4){HG_PK(r0, g0[0], 0), HG_PK(r0, g0[1], 1), HG_PK(r1, g0[2], 0), HG_PK(r1, g0[3], 1)};
                const u32x4 o1 = (u32x4){HG_PK(r2, g1[0], 0), HG_PK(r2, g1[1], 1), HG_PK(r3, g1[2], 0), HG_PK(r3, g1[3], 1)};
#undef HG_PK
                bf16_t* op = MIX + (rowbase + ch * 64 + t) * D + 512 + h * 128 + sg * 16;
                asm volatile("global_store_dwordx4 %0, %1, off\n\ts_nop 1" :: "v"(op), "v"(o0) : "memory");
                asm volatile("global_store_dwordx4 %0, %1, off\n\ts_nop 1" :: "v"(op + 8), "v"(o1) : "memory");
            }
        }
        __syncthreads();
    }
#undef HG_LOAD
#undef HG_LD16
#undef HG_TIES
}
}

__global__ void __launch_bounds__(NTHREADS, 2) mega_fwd(Args args) {
    extern __shared__ __attribute__((aligned(16))) unsigned char lds_raw[];
    cg::grid_group grid = cg::this_grid();
    LAS unsigned char* lds = (LAS unsigned char*)lds_raw;
    const int tid = threadIdx.x, lane = tid & 63, wave = __builtin_amdgcn_readfirstlane(tid >> 6);
    const int G = gridDim.x, gw = blockIdx.x * NWAVES + wave, NGW = G * NWAVES;
    const float* x = args.in[0]; const float* ln1w = args.in[1]; const float* w_in = args.in[2];
    const float* qnw = args.in[3]; const float* knw = args.in[4];
    const float* lq1 = args.in[5]; const float* lk1 = args.in[6]; const float* lq2 = args.in[7]; const float* lk2 = args.in[8];
    const float* sublnw = args.in[9]; const float* lbl = args.in[10]; const float* hnw = args.in[11];
    const float* w_out = args.in[12]; const float* ln2w = args.in[13]; const float* w_up = args.in[14];
    const float* cw = args.in[15]; const float* cb = args.in[16]; const float* w_dn = args.in[17];
    unsigned char* ws = args.ws; float* out = args.out;
    bf16_t* WTin = (bf16_t*)(ws + WS_WIN); bf16_t* WTout = (bf16_t*)(ws + WS_WOUT); bf16_t* WTup = (bf16_t*)(ws + WS_WUP); bf16_t* WTdn = (bf16_t*)(ws + WS_WDN);
    float* SSQ = (float*)(ws + WS_SSQ); float* RS1 = (float*)(ws + WS_RS1);
    bf16_t* XN = (bf16_t*)(ws + WS_XN); bf16_t* PROJ = (bf16_t*)(ws + WS_PROJ); bf16_t* MIX = (bf16_t*)(ws + WS_MIX);
    float* ATT = (float*)(ws + WS_ATT); float* HG = (float*)(ws + WS_HG); bf16_t* X1B = (bf16_t*)(ws + WS_X1B); bf16_t* GB = (bf16_t*)(ws + WS_G);
    float* DL = (float*)(ws + WS_DL);
    float* UL = (float*)(ws + WS_UL); float* U01 = (float*)(ws + WS_U01); float* V01 = (float*)(ws + WS_V01);

    unsigned* ctl = (unsigned*)ws;
    if (tid < 16) ((volatile LAS unsigned*)(lds + LDS_MISC))[tid] = 0u;
    __syncthreads();
    if (args.ws == nullptr) grid.sync();
    const XcdBarrier bar = xcd_barrier_post(ctl + CW_BAR, (volatile LAS unsigned*)(lds + LDS_MISC));
    {
        LAS float* scr = (LAS float*)(lds + wave * 16384);
        constexpr int I_IN = (D / 64) * (NCOLS / 32);
        f32x4 wv[4];
#pragma unroll
        for (int j = 0; j < 4; ++j) wv[j] = ((const f32x4*)ln1w)[lane + 64 * j];
        f32x4 v0[4], v1[4];
        { const f32x4* xr0 = (const f32x4*)(x + (size_t)gw * D); const f32x4* xr1 = (const f32x4*)(x + (size_t)(gw + NGW) * D);
#pragma unroll
          for (int j = 0; j < 4; ++j) { v0[j] = xr0[lane + 64 * j]; v1[j] = xr1[lane + 64 * j]; } }
        for (int it = gw; it < I_IN; it += NGW) p0_transpose_item<2>(w_in, D, NCOLS, WTin, nullptr, scr, it, lane);
        for (int row = gw; row < M; row += 2 * NGW) {
            f32x4 n0[4], n1[4];
            const int nrow = row + 2 * NGW < M ? row + 2 * NGW : row;
            { const f32x4* xr0 = (const f32x4*)(x + (size_t)nrow * D); const f32x4* xr1 = (const f32x4*)(x + (size_t)(nrow + NGW) * D);
#pragma unroll
              for (int j = 0; j < 4; ++j) { n0[j] = xr0[lane + 64 * j]; n1[j] = xr1[lane + 64 * j]; } }
            float s0 = 0.f, s1 = 0.f;
#pragma unroll
            for (int j = 0; j < 4; ++j) { s0 += (v0[j].x * v0[j].x + v0[j].y * v0[j].y) + (v0[j].z * v0[j].z + v0[j].w * v0[j].w); s1 += (v1[j].x * v1[j].x + v1[j].y * v1[j].y) + (v1[j].z * v1[j].z + v1[j].w * v1[j].w); }
            const float ms0 = wave_sum(s0) * (1.f / D) + EPS, ms1 = wave_sum(s1) * (1.f / D) + EPS;
            const float r0 = rsqrtf(ms0), r1 = rsqrtf(ms1);
            if (lane == 0) { RS1[row] = ms0 * r0; RS1[row + NGW] = ms1 * r1; }
#pragma unroll
            for (int j = 0; j < 4; ++j) {
                uint2 o; o.x = pk2(v0[j].x * r0 * wv[j].x, v0[j].y * r0 * wv[j].y); o.y = pk2(v0[j].z * r0 * wv[j].z, v0[j].w * r0 * wv[j].w);
                ((uint2*)(XN + (size_t)row * D))[lane + 64 * j] = o;
                uint2 p; p.x = pk2(v1[j].x * r1 * wv[j].x, v1[j].y * r1 * wv[j].y); p.y = pk2(v1[j].z * r1 * wv[j].z, v1[j].w * r1 * wv[j].w);
                ((uint2*)(XN + (size_t)(row + NGW) * D))[lane + 64 * j] = p; }
#pragma unroll
            for (int j = 0; j < 4; ++j) { v0[j] = n0[j]; v1[j] = n1[j]; }
        }
    }
    xcd_barrier(bar);

    {
        pg8::Gemm g{XN, WTin, M, NCOLS, D, D}; pg8::StaticOrder So; So.init(M, NCOLS, G, (int)blockIdx.x);
        pg8::EpiProj E{PROJ, qnw, knw, QSCALE, lbl, DL, hnw};
        pg8::gemm_phase<pg8::EpiProj, pg8::StaticOrder, true>(lds, g, So, E);
    }
    xcd_barrier(bar);

    {
        if (wave >= 4) __builtin_amdgcn_s_setprio(1);
        if (blockIdx.x < 64) hg::hgrn_unit(lds, PROJ, MIX, DL, hnw, (int)blockIdx.x >> 2, (int)blockIdx.x & 3, tid, lane, wave);
        __syncthreads();
        {
            const float s1 = wave_sum(lq1[lane] * lk1[lane]), s2 = wave_sum(lq2[lane] * lk2[lane]);
            const float lam = __expf(s1) - __expf(s2) + LAM_INIT;
            LAS int* qslot = (LAS int*)(lds + fa::OFF_Q);
            int u = fa::attn_run(lds, PROJ, MIX, sublnw, ctl, lam, tid, lane, wave);
            for (;;) {
                constexpr int I_OUT = (D / 64) * (D / 32), I_UP = (D / 64) * (2 * DFF / 32), I_DN = (DFF / 64) * (D / 32), NCONV = (I_OUT + I_UP + I_DN + 7) / 8;
                if (u >= 1024 + NCONV) break;
                {
                    LAS float* scr = (LAS float*)(lds + wave * 16384);
                    int lane2 = lane; asm volatile("" : "+v"(lane2));
                    int r = (u - 1024) * 8 + wave;
                    if (r < I_OUT) p0_transpose_item<0>(w_out, D, D, WTout, nullptr, scr, r, lane2);
                    else if ((r -= I_OUT) < I_UP) p0_transpose_item<1>(w_up, D, 2 * DFF, WTup, ln2w, scr, r, lane2);
                    else if ((r -= I_UP) < I_DN) p0_transpose_item<0>(w_dn, DFF, D, WTdn, nullptr, scr, r, lane2);
                }
                if (tid == 0) *qslot = (int)__hip_atomic_fetch_add(ctl, 1u, __ATOMIC_RELAXED, __HIP_MEMORY_SCOPE_AGENT);
                __syncthreads();
                u = __builtin_amdgcn_readfirstlane(*qslot);
                __syncthreads();
            }
        }
        __builtin_amdgcn_s_setprio(0);
    }
    xcd_barrier(bar);

    {
        pg8::Gemm g{MIX, WTout, M, D, D, D}; pg8::StaticOrder So; So.init(M, D, G, (int)blockIdx.x);
        pg8::EpiResid<true, false, true, true> E{X1B, nullptr, X1B, SSQ, RS1, ln1w};
        pg8::gemm_phase<pg8::EpiResid<true, false, true, true>, pg8::StaticOrder, true>(lds, g, So, E);
    }
    xcd_barrier(bar);

    {
        pg8::Gemm g{X1B, WTup, M, 2 * DFF, D, D}; pg8::StaticOrder So; So.init(M, 2 * DFF, G, (int)blockIdx.x);
        LAS float* rtab = (LAS float*)(lds + RING_BYTES + 4096);
        {
          f32x4 sv[6][4]; bool ok[6];
#pragma unroll
          for (int k = 0; k < 6; ++k) { pg8::Unit un; const int ui = (tid >> 8) + 2 * k; ok[k] = ui < 11 && So.next(ui, un);
              const f32x4* sp = (const f32x4*)(SSQ + (size_t)((ok[k] ? un.pm : 0) * 256 + (tid & 255)) * 16);
#pragma unroll
              for (int q = 0; q < 4; ++q) sv[k][q] = sp[q]; }
#pragma unroll
          for (int k = 0; k < 6; ++k) if (ok[k]) {
              const f32x4 a = sv[k][0], b_ = sv[k][1], c_ = sv[k][2], d_ = sv[k][3];
              const float s = ((a[0] + a[1]) + (a[2] + a[3])) + ((b_[0] + b_[1]) + (b_[2] + b_[3])) + ((c_[0] + c_[1]) + (c_[2] + c_[3])) + ((d_[0] + d_[1]) + (d_[2] + d_[3]));
              rtab[tid + NTHREADS * k] = rsqrtf(s * (1.f / 1024.f) + EPS); }
          __syncthreads(); }
        pg8::EpiConvGlu E{GB, rtab, cw, cb, UL, U01, V01, (LAS float*)(lds + RING_BYTES)};
        pg8::gemm_phase<pg8::EpiConvGlu, pg8::StaticOrder, true>(lds, g, So, E);
    }
    xcd_barrier(bar);

    {
        pg8::Gemm g{GB, WTdn, M, D, DFF, DFF}; pg8::StaticOrder So; So.init(M, D, G, (int)blockIdx.x);
        pg8::Unit un;
        for (int ui = 0; So.next(ui, un); ++ui) {
            const int pm = un.pm;
            if ((pm & 7) == 0) continue;
            for (int e = tid; e < 2 * DFF; e += NTHREADS) {
                const int j = e / DFF, ch = e - j * DFF;
                const float ua = UL[((size_t)(pm - 1) * 2 + 0) * DFF + ch], ub = UL[((size_t)(pm - 1) * 2 + 1) * DFF + ch];
                const float u0 = U01[((size_t)pm * 2 + 0) * DFF + ch], u1 = U01[((size_t)pm * 2 + 1) * DFF + ch];
                const float um2 = j ? ub : ua, um1 = j ? u0 : ub, uc = j ? u1 : u0;
                const float c = cb[ch] + cw[ch] * um2 + cw[DFF + ch] * um1 + cw[2 * DFF + ch] * uc;
                GB[((size_t)pm * 256 + j) * DFF + ch] = (bf16_t)f2bf(c * sigmoidf_(c) * V01[((size_t)pm * 2 + j) * DFF + ch]);
            }
        }
        asm volatile("s_waitcnt vmcnt(0)" ::: "memory");
        __syncthreads();
        pg8::EpiResid<true, true, false> E{X1B, out, nullptr, nullptr, nullptr, nullptr};
        pg8::gemm_phase<pg8::EpiResid<true, true, false>, pg8::StaticOrder, true>(lds, g, So, E);
    }
}

extern "C" void kernel_launch(void* const* d_in, const int* in_sizes, int n_in, void* d_out, int out_size, void* d_ws, size_t ws_size, hipStream_t stream) {
    static int grid_blocks = 0;
    if (grid_blocks == 0) {
        if (n_in != 18 || in_sizes[0] != M * D || out_size != M * D || ws_size < WS_NEED) { fprintf(stderr, "kernel_launch: unexpected shapes: n_in %d in0 %d out %d ws %zu\n", n_in, n_in > 0 ? in_sizes[0] : -1, out_size, ws_size); grid_blocks = -1; return; }
        int dev = 0, cus = 0, per_cu = 0;
        if (hipGetDevice(&dev) != hipSuccess || hipDeviceGetAttribute(&cus, hipDeviceAttributeMultiprocessorCount, dev) != hipSuccess) { grid_blocks = -1; return; }
        if (hipFuncSetAttribute((const void*)mega_fwd, hipFuncAttributeMaxDynamicSharedMemorySize, LDS_BYTES) != hipSuccess) { fprintf(stderr, "kernel_launch: hipFuncSetAttribute failed\n"); grid_blocks = -1; return; }
        if (hipOccupancyMaxActiveBlocksPerMultiprocessor(&per_cu, (const void*)mega_fwd, NTHREADS, LDS_BYTES) != hipSuccess || per_cu < 1) { fprintf(stderr, "kernel_launch: occupancy query failed (%d)\n", per_cu); (void)hipGetLastError(); grid_blocks = -1; return; }
        grid_blocks = cus * (per_cu > 1 ? 1 : per_cu);
    }
    if (grid_blocks < 0) return;
    if (hipMemsetAsync(d_ws, 0, 65536, stream) != hipSuccess) { fprintf(stderr, "kernel_launch: hipMemsetAsync failed\n"); return; }
    Args a{};
    for (int i = 0; i < 18; ++i) a.in[i] = (const float*)d_in[i];
    a.out = (float*)d_out; a.ws = (unsigned char*)d_ws;
    void* kargs[] = {&a};
    hipError_t e = hipLaunchCooperativeKernel((const void*)mega_fwd, dim3(grid_blocks), dim3(NTHREADS), kargs, LDS_BYTES, stream);
    if (e != hipSuccess) fprintf(stderr, "cooperative launch failed: %s (grid %d)\n", hipGetErrorString(e), grid_blocks);
}
```

```cpp
#include <hip/hip_runtime.h>
#include <hip/hip_cooperative_groups.h>
#include <stdint.h>
#include <cstdio>
namespace cg = cooperative_groups;

constexpr int D = 1024, NB = 16, S = 2048, M = NB * S;
constexpr int NH = 4, NCOLS = 3584, DFF = 2816;
constexpr int OFF_DQ = 0, OFF_DK = 512, OFF_DV = 1024, OFF_HQ = 1536, OFF_HF = 2048, OFF_HI = 2560, OFF_HG = 3072;
constexpr float EPS = 1e-6f;
constexpr float LAM_INIT = 0.2f;

namespace pg8 {
#define PG8_LAS __attribute__((address_space(3)))
typedef unsigned short bf16_t;
typedef short bf16x8 __attribute__((ext_vector_type(8)));
typedef float f32x4 __attribute__((ext_vector_type(4)));
typedef unsigned u32x4 __attribute__((ext_vector_type(4)));
constexpr int BM = 256, BK = 64, HALF = 128, HTB = HALF * BK * 2, STAGE_BYTES = 8 * HTB, NXCD = 8, WGM = 8;

__host__ __device__ __forceinline__ int lds_byte(int r, int c) { const int st = (r >> 4) * 2 + (c >> 5), rr = r & 15, cc = c & 31, ob = rr * 64 + cc * 2; return st * 1024 + (ob ^ (((ob >> 9) & 1) << 5)); }
__host__ __device__ __forceinline__ void stage_rc(int b, int& R, int& C) { const int st = b / 1024, sb = b % 1024, swz = sb ^ (((sb >> 9) & 1) << 5); R = (st >> 1) * 16 + swz / 64; C = (st & 1) * 32 + (swz % 64) / 2; }
__host__ __device__ __forceinline__ int perm32(int rho) { const int n = rho >> 4, i = rho & 15; return 8 * (i >> 2) + 4 * n + (i & 3); }

struct Unit { int pm, pn; };
struct Gemm { const bf16_t* A; const bf16_t* Bt; int M, N, K, lda; };

struct StaticOrder {
    int nM, nN, nwg, G, c;
    __host__ __device__ void init(int M_, int N_, int G_, int c_) { nM = M_ / BM; nN = N_ / BM; nwg = nM * nN; G = G_; c = c_; }
    __host__ __device__ bool next(int i, Unit& u) const {
        const long L = (long)i * G + c; if (L >= nwg) return false;
        int wgid = (int)L; { const int q = nwg / NXCD, r = nwg % NXCD, xcd = wgid % NXCD, off = wgid / NXCD; wgid = (xcd < r ? xcd * (q + 1) : r * (q + 1) + (xcd - r) * q) + off; }
        const int nig = WGM * nN, gid = wgid / nig, fm = gid * WGM, gsz = (nM - fm) < WGM ? (nM - fm) : WGM;
        u.pm = fm + ((wgid % nig) % gsz); u.pn = (wgid % nig) / gsz; return true;
    }
    __device__ __forceinline__ void a_ready(const Unit&) const {}
    __device__ __forceinline__ void done(const Unit&) const {}
};

__device__ __forceinline__ unsigned cvt_pk_bf16(float lo, float hi) { unsigned r; asm volatile("v_cvt_pk_bf16_f32 %0, %1, %2" : "=v"(r) : "v"(lo), "v"(hi)); return r; }
typedef unsigned st_u32x4 __attribute__((ext_vector_type(4)));
typedef float st_f32x4 __attribute__((ext_vector_type(4)));
__device__ __forceinline__ void st_nt(void* p, st_u32x4 v) { __builtin_nontemporal_store(v, (st_u32x4*)p); }
__device__ __forceinline__ void st_nt(void* p, st_f32x4 v) { __builtin_nontemporal_store(v, (st_f32x4*)p); }


struct EpiBf16 {
    static constexpr bool PERM = true, AFTER_DRAIN = false;
    bf16_t* O; int ldc; const float* ssq;
    __device__ __forceinline__ void operator()(const f32x4 (&acc)[2][2][4][2], const Unit& u, int wr, int wc, int fr, int fq, int ui) const {
        const int row0 = u.pm * BM + wr * 64 + fr, col0 = u.pn * BM + wc * 32 + 8 * fq;
#pragma unroll
        for (int ai = 0; ai < 2; ++ai)
#pragma unroll
            for (int m = 0; m < 4; ++m) {
                const int row = row0 + ai * HALF + m * 16;
                float sc = 1.f;
                if (ssq) { const f32x4* sp = (const f32x4*)(ssq + (size_t)row * 16); const f32x4 a = sp[0], b = sp[1], c = sp[2], d = sp[3];
                    const float s = ((a[0] + a[1]) + (a[2] + a[3])) + ((b[0] + b[1]) + (b[2] + b[3])) + ((c[0] + c[1]) + (c[2] + c[3])) + ((d[0] + d[1]) + (d[2] + d[3]));
                    sc = rsqrtf(s * (1.f / 1024.f) + EPS); }
                bf16_t* rowp = O + (size_t)row * ldc + col0;
#pragma unroll
                for (int bj = 0; bj < 2; ++bj) { const f32x4 v0 = acc[ai][bj][m][0] * sc, v1 = acc[ai][bj][m][1] * sc;
                    u32x4 w; w.x = cvt_pk_bf16(v0[0], v0[1]); w.y = cvt_pk_bf16(v0[2], v0[3]); w.z = cvt_pk_bf16(v1[0], v1[1]); w.w = cvt_pk_bf16(v1[2], v1[3]);
                    *(u32x4*)(rowp + bj * HALF) = w; }
            }
    }
};

struct EpiProj {
    static constexpr bool PERM = true, AFTER_DRAIN = false;
    bf16_t* O; const float* qw; const float* kw; float qscale; const float* lbl; float* DL; const float* hnw;
    __device__ __forceinline__ void operator()(const f32x4 (&acc)[2][2][4][2], const Unit& u, int wr, int wc, int fr, int fq, int ui) const {
        const int row0 = u.pm * BM + wr * 64 + fr;
        if (u.pn < 4) {
            const float* w = (u.pn < 2) ? qw : kw; const float sc = (u.pn < 2) ? qscale : 1.f;
            const int col0 = u.pn * BM + 64 * wc + 8 * fq;
            f32x4 wq0[2], wq1[2];
#pragma unroll
            for (int bj = 0; bj < 2; ++bj) { wq0[bj] = *(const f32x4*)(w + 32 * bj + 8 * fq); wq1[bj] = *(const f32x4*)(w + 32 * bj + 8 * fq + 4); }
            float rr[2][4];
#pragma unroll
            for (int ai = 0; ai < 2; ++ai)
#pragma unroll
                for (int m = 0; m < 4; ++m) {
                    float ss = 0.f;
#pragma unroll
                    for (int bj = 0; bj < 2; ++bj)
#pragma unroll
                        for (int n = 0; n < 2; ++n) { const f32x4 v = acc[ai][bj][m][n]; ss += (v[0] * v[0] + v[1] * v[1]) + (v[2] * v[2] + v[3] * v[3]); }
                    ss += __shfl_xor(ss, 16); ss += __shfl_xor(ss, 32);
                    rr[ai][m] = rsqrtf(ss * (1.f / 64.f) + EPS) * sc;
                }
#pragma unroll
            for (int bj = 0; bj < 2; ++bj) {
                const f32x4 w0 = wq0[bj], w1 = wq1[bj];
#pragma unroll
                for (int ai = 0; ai < 2; ++ai)
#pragma unroll
                    for (int m = 0; m < 4; ++m) {
                        const f32x4 v0 = acc[ai][bj][m][0] * rr[ai][m] * w0, v1 = acc[ai][bj][m][1] * rr[ai][m] * w1;
                        u32x4 o; o.x = cvt_pk_bf16(v0[0], v0[1]); o.y = cvt_pk_bf16(v0[2], v0[3]); o.z = cvt_pk_bf16(v1[0], v1[1]); o.w = cvt_pk_bf16(v1[2], v1[3]);
                        st_nt(O + (size_t)(row0 + ai * HALF + m * 16) * NCOLS + col0 + 32 * bj, o);
                    }
                asm volatile("" ::: "memory");
            }
        } else if (u.pn >= 6 && u.pn < 10) {
            const int h = u.pn - 6, k0 = wc * 32 + 8 * fq, lane_ = fq * 16 + fr, ad15 = (lane_ | 15) << 2;
#define EP_DPP_MUL(x, ctrl) x *= __int_as_float(__builtin_amdgcn_update_dpp(0x3f800000, __float_as_int(x), ctrl, 0xf, 0xf, false))
            f32x4 lb[2];
#pragma unroll
            for (int n = 0; n < 2; ++n) { const f32x4 l0 = *(const f32x4*)(lbl + h * 128 + k0 + 4 * n), l1 = *(const f32x4*)(lbl + 512 + h * 128 + k0 + 4 * n);
#pragma unroll
                for (int i = 0; i < 4; ++i) lb[n][i] = __builtin_amdgcn_rcpf(1.f + __builtin_amdgcn_exp2f((l1[i] - l0[i]) * 1.4426950408889634f)); }
#pragma unroll
            for (int ai = 0; ai < 2; ++ai) {
                f32x4 bc[2][4], om[2][4];
#pragma unroll
                for (int n = 0; n < 2; ++n) {
#pragma unroll
                    for (int m = 0; m < 4; ++m)
#pragma unroll
                        for (int i = 0; i < 4; ++i) {
                            const float z = acc[ai][1][m][n][i];
                            const float f = lb[n][i] + (1.f - lb[n][i]) * __builtin_amdgcn_rcpf(1.f + __builtin_amdgcn_exp2f(-1.4426950408889634f * z));
                            om[n][m][i] = 1.f - f; bc[n][m][i] = f;
                        }
#pragma unroll
                    for (int m = 0; m < 4; ++m)
#pragma unroll
                        for (int i = 0; i < 4; ++i) { EP_DPP_MUL(bc[n][m][i], 0x111); EP_DPP_MUL(bc[n][m][i], 0x112); EP_DPP_MUL(bc[n][m][i], 0x114); EP_DPP_MUL(bc[n][m][i], 0x118); }
#pragma unroll
                    for (int m = 1; m < 4; ++m)
#pragma unroll
                        for (int i = 0; i < 4; ++i) bc[n][m][i] *= __int_as_float(__builtin_amdgcn_ds_bpermute(ad15, __float_as_int(bc[n][m - 1][i])));
                }
                const int rc = u.pm * BM + ai * HALF + wr * 64;
#pragma unroll
                for (int m = 0; m < 4; ++m) {
                    unsigned wq[4], wk[4];
#pragma unroll
                    for (int n = 0; n < 2; ++n) {
                        const f32x4 q = acc[ai][0][m][n];
                        float qt[4], kt[4];
#pragma unroll
                        for (int i = 0; i < 4; ++i) { qt[i] = q[i] * bc[n][m][i]; kt[i] = om[n][m][i] * __builtin_amdgcn_rcpf(bc[n][m][i]); }
                        wq[2 * n] = cvt_pk_bf16(qt[0], qt[1]); wq[2 * n + 1] = cvt_pk_bf16(qt[2], qt[3]); wk[2 * n] = cvt_pk_bf16(kt[0], kt[1]); wk[2 * n + 1] = cvt_pk_bf16(kt[2], kt[3]);
                    }
                    bf16_t* rp = O + (size_t)(rc + m * 16 + fr) * NCOLS + h * 128 + k0;
                    st_nt(rp + OFF_HQ, (u32x4){wq[0], wq[1], wq[2], wq[3]});
                    st_nt(rp + OFF_HF, (u32x4){wk[0], wk[1], wk[2], wk[3]});
                }
                if (fr == 15) {
                    float* dp = DL + (size_t)(((rc >> 11) * 4 + h) * 32 + ((rc & 2047) >> 6)) * 128 + k0;
                    *(f32x4*)dp = bc[0][3]; *(f32x4*)(dp + 4) = bc[1][3];
                }
                asm volatile("" ::: "memory");
            }
#undef EP_DPP_MUL
        } else if (u.pn >= 12) {
            const int col0 = u.pn * BM + wc * 32 + 8 * fq;
            const f32x4 w0 = *(const f32x4*)(hnw + wc * 32 + 8 * fq), w1 = *(const f32x4*)(hnw + wc * 32 + 8 * fq + 4);
#pragma unroll
            for (int ai = 0; ai < 2; ++ai)
#pragma unroll
                for (int m = 0; m < 4; ++m) {
                    bf16_t* rowp = O + (size_t)(row0 + ai * HALF + m * 16) * NCOLS + col0;
#pragma unroll
                    for (int bj = 0; bj < 2; ++bj) { f32x4 v0 = acc[ai][bj][m][0], v1 = acc[ai][bj][m][1];
#pragma unroll
                        for (int i = 0; i < 4; ++i) { v0[i] *= w0[i] * __builtin_amdgcn_rcpf(1.f + __builtin_amdgcn_exp2f(-1.4426950408889634f * v0[i]));
                                                      v1[i] *= w1[i] * __builtin_amdgcn_rcpf(1.f + __builtin_amdgcn_exp2f(-1.4426950408889634f * v1[i])); }
                        u32x4 o; o.x = cvt_pk_bf16(v0[0], v0[1]); o.y = cvt_pk_bf16(v0[2], v0[3]); o.z = cvt_pk_bf16(v1[0], v1[1]); o.w = cvt_pk_bf16(v1[2], v1[3]);
                        st_nt(rowp + bj * HALF, o); }
                }
        } else {
            const int col0 = u.pn * BM + wc * 32 + 8 * fq;
#pragma unroll
            for (int ai = 0; ai < 2; ++ai)
#pragma unroll
                for (int m = 0; m < 4; ++m) {
                    bf16_t* rowp = O + (size_t)(row0 + ai * HALF + m * 16) * NCOLS + col0;
#pragma unroll
                    for (int bj = 0; bj < 2; ++bj) { const f32x4 v0 = acc[ai][bj][m][0], v1 = acc[ai][bj][m][1];
                        u32x4 o; o.x = cvt_pk_bf16(v0[0], v0[1]); o.y = cvt_pk_bf16(v0[2], v0[3]); o.z = cvt_pk_bf16(v1[0], v1[1]); o.w = cvt_pk_bf16(v1[2], v1[3]);
                        st_nt(rowp + bj * HALF, o); }
                }
        }
    }
};

template <bool BF16BASE, bool F32OUT, bool XBOUT, bool SCALED = false>
struct EpiResid {
    static constexpr bool PERM = true, AFTER_DRAIN = false;
    const void* base; float* out; bf16_t* xb; float* ssq; const float* rscale; const float* cw;
    __device__ __forceinline__ void operator()(const f32x4 (&acc)[2][2][4][2], const Unit& u, int wr, int wc, int fr, int fq, int ui) const {
        const int row0 = u.pm * BM + wr * 64 + fr, col0 = u.pn * BM + wc * 32 + 8 * fq;
        f32x4 ic[2][2];
        if (SCALED) {
#pragma unroll
            for (int bj = 0; bj < 2; ++bj)
#pragma unroll
                for (int n = 0; n < 2; ++n) { const f32x4 w = *(const f32x4*)(cw + col0 + bj * HALF + 4 * n); ic[bj][n] = (f32x4){__builtin_amdgcn_rcpf(w[0]), __builtin_amdgcn_rcpf(w[1]), __builtin_amdgcn_rcpf(w[2]), __builtin_amdgcn_rcpf(w[3])}; }
        }
#pragma unroll
        for (int ai = 0; ai < 2; ++ai) {
            u32x4 pb[4][2]; f32x4 pf[4][2][2]; float rsc[4];
            if (SCALED) {
#pragma unroll
                for (int m = 0; m < 4; ++m) rsc[m] = rscale[row0 + ai * HALF + m * 16];
            }
#pragma unroll
            for (int m = 0; m < 4; ++m)
#pragma unroll
                for (int bj = 0; bj < 2; ++bj) { const size_t off = (size_t)(row0 + ai * HALF + m * 16) * D + col0 + bj * HALF;
                    if (BF16BASE) pb[m][bj] = *(const u32x4*)((const bf16_t*)base + off);
                    else { pf[m][bj][0] = *(const f32x4*)((const float*)base + off); pf[m][bj][1] = *(const f32x4*)((const float*)base + off + 4); } }
#pragma unroll
            for (int m = 0; m < 4; ++m) {
                const int row = row0 + ai * HALF + m * 16; const size_t off = (size_t)row * D + col0;
                float ss = 0.f;
#pragma unroll
                for (int bj = 0; bj < 2; ++bj) {
                    f32x4 b0, b1;
                    if (BF16BASE) { const u32x4 w = pb[m][bj];
                        b0 = (f32x4){__uint_as_float(w.x << 16), __uint_as_float(w.x & 0xffff0000u), __uint_as_float(w.y << 16), __uint_as_float(w.y & 0xffff0000u)};
                        b1 = (f32x4){__uint_as_float(w.z << 16), __uint_as_float(w.z & 0xffff0000u), __uint_as_float(w.w << 16), __uint_as_float(w.w & 0xffff0000u)}; }
                    else { b0 = pf[m][bj][0]; b1 = pf[m][bj][1]; }
                    if (SCALED) { b0 = b0 * rsc[m] * ic[bj][0]; b1 = b1 * rsc[m] * ic[bj][1]; }
                    const f32x4 v0 = acc[ai][bj][m][0] + b0, v1 = acc[ai][bj][m][1] + b1;
                    if (F32OUT) { st_nt(out + off + bj * HALF, v0); st_nt(out + off + bj * HALF + 4, v1); }
                    if (XBOUT) { u32x4 w; w.x = cvt_pk_bf16(v0[0], v0[1]); w.y = cvt_pk_bf16(v0[2], v0[3]); w.z = cvt_pk_bf16(v1[0], v1[1]); w.w = cvt_pk_bf16(v1[2], v1[3]); st_nt(xb + off + bj * HALF, w);
                        ss += ((v0[0] * v0[0] + v0[1] * v0[1]) + (v0[2] * v0[2] + v0[3] * v0[3])) + ((v1[0] * v1[0] + v1[1] * v1[1]) + (v1[2] * v1[2] + v1[3] * v1[3])); }
                }
                if (XBOUT) { ss += __shfl_xor(ss, 16); ss += __shfl_xor(ss, 32); if (fq == 0) ssq[(size_t)row * 16 + u.pn * 4 + wc] = ss; }
            }
            asm volatile("" ::: "memory");
        }
    }
};

struct EpiConvGlu {
    static constexpr bool PERM = true, AFTER_DRAIN = false;
    bf16_t* G; const PG8_LAS float* rtab; const float* cw; const float* cb; float* UL; float* U01; float* V01; PG8_LAS float* hx;
    __device__ __forceinline__ void operator()(const f32x4 (&acc)[2][2][4][2], const Unit& u, int wr, int wc, int fr, int fq, int ui) const {
        const int ch0 = u.pn * HALF + wc * 32 + 8 * fq, row0 = u.pm * BM + wr * 64 + fr;
        f32x4 cbv[2], w0v[2], w1v[2], w2v[2];
#pragma unroll
        for (int n = 0; n < 2; ++n) { cbv[n] = *(const f32x4*)(cb + ch0 + 4 * n); w0v[n] = *(const f32x4*)(cw + ch0 + 4 * n); w1v[n] = *(const f32x4*)(cw + DFF + ch0 + 4 * n); w2v[n] = *(const f32x4*)(cw + 2 * DFF + ch0 + 4 * n); }
        float rs[2][4];
#pragma unroll
        for (int ai = 0; ai < 2; ++ai)
#pragma unroll
            for (int m = 0; m < 4; ++m) rs[ai][m] = rtab[ui * BM + ai * HALF + wr * 64 + m * 16 + fr];
#pragma unroll
        for (int ai = 0; ai < 2; ++ai) {
            if (fr >= 14) {
                PG8_LAS float* hp = hx + ((2 * ai + wr) * 4 + wc) * 64 + (fr - 14) * 32 + 8 * fq;
                *(PG8_LAS f32x4*)hp = acc[ai][0][3][0] * rs[ai][3]; *(PG8_LAS f32x4*)(hp + 4) = acc[ai][0][3][1] * rs[ai][3];
            }
        }
        if (wr == 1 && fr >= 14) { float* p = UL + ((size_t)u.pm * 2 + (fr - 14)) * DFF + ch0; *(f32x4*)p = acc[1][0][3][0] * rs[1][3]; *(f32x4*)(p + 4) = acc[1][0][3][1] * rs[1][3]; }
        if (wr == 0 && fr < 2) { float* p = U01 + ((size_t)u.pm * 2 + fr) * DFF + ch0; *(f32x4*)p = acc[0][0][0][0] * rs[0][0]; *(f32x4*)(p + 4) = acc[0][0][0][1] * rs[0][0];
                                 float* q = V01 + ((size_t)u.pm * 2 + fr) * DFF + ch0; *(f32x4*)q = acc[0][1][0][0] * rs[0][0]; *(f32x4*)(q + 4) = acc[0][1][0][1] * rs[0][0]; }
        asm volatile("s_waitcnt lgkmcnt(0)" ::: "memory"); __builtin_amdgcn_s_barrier(); asm volatile("" ::: "memory");
        const int lane = fq * 16 + fr;
        const bool is15 = (fr == 15), ge14 = (fr >= 14);
        typedef _Float16 h2 __attribute__((ext_vector_type(2)));
#define CG_PK(a_, b_) __builtin_bit_cast(h2, __builtin_amdgcn_cvt_pkrtz((a_), (b_)))
        const h2 mL2 = {(_Float16)-1.4426950408889634f, (_Float16)-1.4426950408889634f}, one2 = {(_Float16)1.f, (_Float16)1.f};
        h2 cb2[2][2], w02[2][2], w12[2][2], w22[2][2];
#pragma unroll
        for (int n = 0; n < 2; ++n)
#pragma unroll
            for (int p = 0; p < 2; ++p) { cb2[n][p] = CG_PK(cbv[n][2 * p], cbv[n][2 * p + 1]); w02[n][p] = CG_PK(w0v[n][2 * p], w0v[n][2 * p + 1]); w12[n][p] = CG_PK(w1v[n][2 * p], w1v[n][2 * p + 1]); w22[n][p] = CG_PK(w2v[n][2 * p], w2v[n][2 * p + 1]); }
#pragma unroll
        for (int ai = 0; ai < 2; ++ai) {
            const int gi = 2 * ai + wr;
            h2 prev[2][2];
#pragma unroll
            for (int n = 0; n < 2; ++n) {
                prev[n][0] = (h2){(_Float16)0.f, (_Float16)0.f}; prev[n][1] = prev[n][0];
                if (gi != 0) { const f32x4 pf_ = *(const PG8_LAS f32x4*)(hx + ((gi - 1) * 4 + wc) * 64 + (fr & 1) * 32 + 8 * fq + 4 * n); prev[n][0] = CG_PK(pf_[0], pf_[1]); prev[n][1] = CG_PK(pf_[2], pf_[3]); }
            }
#pragma unroll
            for (int m = 0; m < 4; ++m) {
                const float r_ = rs[ai][m]; const h2 r2 = {(_Float16)r_, (_Float16)r_};
                unsigned w[4];
#pragma unroll
                for (int n = 0; n < 2; ++n) {
                    const f32x4 uf = acc[ai][0][m][n], vf_ = acc[ai][1][m][n];
#pragma unroll
                    for (int p = 0; p < 2; ++p) {
                        const h2 cur = CG_PK(uf[2 * p], uf[2 * p + 1]) * r2;
                        const h2 vv = CG_PK(vf_[2 * p], vf_[2 * p + 1]) * r2;
                        const int ci = __builtin_bit_cast(int, cur), pi = __builtin_bit_cast(int, prev[n][p]);
                        const h2 s1 = __builtin_bit_cast(h2, __builtin_amdgcn_update_dpp(0, is15 ? pi : ci, 0x121, 0xf, 0xf, false));
                        const h2 s2 = __builtin_bit_cast(h2, __builtin_amdgcn_update_dpp(0, ge14 ? pi : ci, 0x122, 0xf, 0xf, false));
                        const h2 c = cb2[n][p] + w02[n][p] * s2 + w12[n][p] * s1 + w22[n][p] * cur;
                        const h2 t = c * mL2;
                        h2 e2; e2[0] = (_Float16)__builtin_exp2f16(t[0]); e2[1] = (_Float16)__builtin_exp2f16(t[1]);
                        const h2 d = e2 + one2;
                        h2 sg; sg[0] = (_Float16)__builtin_amdgcn_rcph(d[0]); sg[1] = (_Float16)__builtin_amdgcn_rcph(d[1]);
                        const h2 g2 = c * sg * vv;
                        w[2 * n + p] = cvt_pk_bf16((float)g2[0], (float)g2[1]);
                        prev[n][p] = cur;
                    }
                }
                st_nt(G + (size_t)(row0 + ai * HALF + m * 16) * DFF + ch0, (u32x4){w[0], w[1], w[2], w[3]});
                asm volatile("" ::: "memory");
            }
        }
#undef CG_PK
    }
};

template <class Epi, class Sched, bool ALIGN_EPI>
__device__ __forceinline__ void gemm_phase(PG8_LAS unsigned char* lds, const Gemm g, const Sched& S, const Epi& E) {
    int tid = threadIdx.x; asm volatile("" : "+v"(tid));
    const int wid = __builtin_amdgcn_readfirstlane(tid >> 6), lane = tid & 63, wr = wid >> 2, wc = wid & 3, fr = lane & 15, fq = lane >> 4;
    const int K = g.K, nt = K / BK, lda = g.lda;
    unsigned voffA[2], voffB[2];
#pragma unroll
    for (int i = 0; i < 2; ++i) { int R, C; stage_rc(tid * 16 + i * 8192, R, C); const int Rb = Epi::PERM ? ((R & ~31) + perm32(R & 31)) : R;
        voffA[i] = (unsigned)(R * lda + C) * 2u; voffB[i] = (unsigned)(Rb * K + C) * 2u; }
    const size_t kstep = (size_t)(BK * 2);
    const size_t hstepA = (size_t)HALF * lda * 2, hstepB = (size_t)HALF * K * 2;
    const size_t tstepA = 2 * hstepA, tstepB = 2 * hstepB;
    const unsigned ldsw = (unsigned)wid * 1024u;
    const int aoff = lds_byte(wr * 64 + fr, fq * 8), boff = lds_byte(wc * 32 + fr, fq * 8);
#define PG8_SA(b, h) (((b) * 2 + (h)) * HTB)
#define PG8_SB(b, h) ((4 + (b) * 2 + (h)) * HTB)
#define PG8_STAGE(bufoff, gbase, voff) do { _Pragma("unroll") for (int _i = 0; _i < 2; ++_i) \
        __builtin_amdgcn_global_load_lds((const unsigned*)((const char*)(gbase) + (voff)[_i]), (PG8_LAS unsigned*)(lds + (bufoff) + ldsw + _i * 8192), 16, 0, 0); } while (0)
#define PG8_LDA(dst, b, h) do { _Pragma("unroll") for (int m = 0; m < 4; ++m) _Pragma("unroll") for (int k = 0; k < 2; ++k) dst[m][k] = *(const PG8_LAS bf16x8*)(lds + PG8_SA(b, h) + aoff + m * 2048 + k * 1024); } while (0)
#define PG8_LDB(dst, b, h) do { _Pragma("unroll") for (int n = 0; n < 2; ++n) _Pragma("unroll") for (int k = 0; k < 2; ++k) dst[n][k] = *(const PG8_LAS bf16x8*)(lds + PG8_SB(b, h) + boff + n * 2048 + k * 1024); } while (0)
#define PG8_MMA(ai, bj, At, Bt) do { __builtin_amdgcn_s_setprio(1); _Pragma("unroll") for (int m = 0; m < 4; ++m) _Pragma("unroll") for (int n = 0; n < 2; ++n) _Pragma("unroll") for (int k = 0; k < 2; ++k) \
        acc[ai][bj][m][n] = __builtin_amdgcn_mfma_f32_16x16x32_bf16(Bt[n][k], At[m][k], acc[ai][bj][m][n], 0, 0, 0); __builtin_amdgcn_s_setprio(0); } while (0)
#define PG8_WAIT_V(n) asm volatile("s_waitcnt vmcnt(" #n ")" ::: "memory")
#define PG8_WAIT_L(n) asm volatile("s_waitcnt lgkmcnt(" #n ")" ::: "memory")
#define PG8_BAR __builtin_amdgcn_s_barrier()
#define PG8_SCHED __builtin_amdgcn_sched_barrier(0)
    Unit cur, nxt; int ui = 0;
    if (!S.next(0, cur)) return;
    f32x4 acc[2][2][4][2];
#pragma unroll
    for (int a = 0; a < 2; ++a)
#pragma unroll
        for (int b = 0; b < 2; ++b)
#pragma unroll
            for (int m = 0; m < 4; ++m)
#pragma unroll
                for (int n = 0; n < 2; ++n) acc[a][b][m][n] = (f32x4){0.f, 0.f, 0.f, 0.f};
    bf16x8 At[4][2], B0[2][2], B1[2][2];
    const char* cA = (const char*)g.A + (size_t)cur.pm * tstepA; const char* cB = (const char*)g.Bt + (size_t)cur.pn * tstepB;
    S.a_ready(cur);
    PG8_STAGE(PG8_SB(0, 0), cB, voffB); PG8_STAGE(PG8_SB(0, 1), cB + hstepB, voffB); PG8_STAGE(PG8_SA(0, 0), cA, voffA); PG8_STAGE(PG8_SA(0, 1), cA + hstepA, voffA);
    if (wr == 1) PG8_BAR;
    PG8_WAIT_V(2); PG8_BAR;
    PG8_STAGE(PG8_SB(1, 0), cB + kstep, voffB); PG8_STAGE(PG8_SA(1, 0), cA + kstep, voffA); PG8_STAGE(PG8_SB(1, 1), cB + hstepB + kstep, voffB);
    PG8_WAIT_V(6); PG8_BAR;
    for (;;) {
        const bool has_next = S.next(ui + 1, nxt);
        const char* nA = has_next ? (const char*)g.A + (size_t)nxt.pm * tstepA : cA; const char* nB = has_next ? (const char*)g.Bt + (size_t)nxt.pn * tstepB : cB;
        for (int t = 0; t < nt; t += 2) {
            const bool last = (t == nt - 2);
            const char* a1 = cA + (size_t)(t + 1) * kstep;
            const char* a2 = last ? nA : cA + (size_t)(t + 2) * kstep; const char* b2 = last ? nB : cB + (size_t)(t + 2) * kstep;
            const char* a3 = a2 + kstep; const char* b3 = b2 + kstep;
            if (last && has_next) S.a_ready(nxt);
            PG8_LDB(B0, 0, 0); PG8_LDB(B1, 0, 1); PG8_SCHED; PG8_LDA(At, 0, 0); PG8_STAGE(PG8_SA(1, 1), a1 + hstepA, voffA);
            PG8_WAIT_V(8); PG8_WAIT_L(0); PG8_BAR; PG8_MMA(0, 0, At, B0); PG8_MMA(0, 1, At, B1); PG8_BAR; PG8_SCHED;
            PG8_LDA(At, 0, 1); PG8_STAGE(PG8_SB(0, 0), b2, voffB); PG8_STAGE(PG8_SB(0, 1), b2 + hstepB, voffB); PG8_STAGE(PG8_SA(0, 0), a2, voffA);
            PG8_WAIT_V(8); PG8_WAIT_L(0); PG8_BAR; PG8_MMA(1, 0, At, B0); PG8_MMA(1, 1, At, B1); PG8_BAR; PG8_SCHED;
            PG8_LDB(B0, 1, 0); PG8_LDB(B1, 1, 1); PG8_SCHED; PG8_LDA(At, 1, 0); PG8_STAGE(PG8_SA(0, 1), a2 + hstepA, voffA);
            PG8_WAIT_V(8); PG8_WAIT_L(0); PG8_BAR; PG8_MMA(0, 0, At, B0); PG8_MMA(0, 1, At, B1); PG8_BAR; PG8_SCHED;
            PG8_LDA(At, 1, 1); PG8_STAGE(PG8_SB(1, 0), b3, voffB); PG8_STAGE(PG8_SB(1, 1), b3 + hstepB, voffB); PG8_STAGE(PG8_SA(1, 0), a3, voffA);
            PG8_WAIT_V(8); PG8_WAIT_L(0); PG8_BAR; PG8_MMA(1, 0, At, B0); PG8_MMA(1, 1, At, B1); PG8_BAR; PG8_SCHED;
        }
        if constexpr (ALIGN_EPI) { if (wr == 0) PG8_BAR; }
        E(acc, cur, wr, wc, fr, fq, ui); S.done(cur);
        if (!has_next) break;
#pragma unroll
        for (int a = 0; a < 2; ++a)
#pragma unroll
            for (int b = 0; b < 2; ++b)
#pragma unroll
                for (int m = 0; m < 4; ++m)
#pragma unroll
                    for (int n = 0; n < 2; ++n) acc[a][b][m][n] = (f32x4){0.f, 0.f, 0.f, 0.f};
        cur = nxt; cA = nA; cB = nB; ++ui;
        if constexpr (ALIGN_EPI) { if (wr == 1) PG8_BAR; }
    }
    PG8_WAIT_V(0);
    if constexpr (!ALIGN_EPI) { if (wr == 0) PG8_BAR; }
    PG8_BAR;
#undef PG8_SA
#undef PG8_SB
#undef PG8_STAGE
#undef PG8_LDA
#undef PG8_LDB
#undef PG8_MMA
#undef PG8_WAIT_V
#undef PG8_WAIT_L
#undef PG8_BAR
#undef PG8_SCHED
}
}

#define LAS __attribute__((address_space(3)))
typedef unsigned short bf16_t;
typedef float f32x4 __attribute__((ext_vector_type(4)));
typedef unsigned u32x4 __attribute__((ext_vector_type(4)));
typedef unsigned u32x2 __attribute__((ext_vector_type(2)));
constexpr int NWAVES = 8, NTHREADS = 512;
constexpr int LDS_BYTES = 147456;
constexpr int RING_BYTES = 131072;

constexpr size_t MiB = 1u << 20;
constexpr size_t WS_WIN = 1 * MiB, WS_WOUT = 9 * MiB, WS_WUP = 12 * MiB, WS_WDN = 24 * MiB;
constexpr size_t WS_RS1 = 29 * MiB + 768 * 1024;
constexpr size_t WS_SSQ = 30 * MiB;
constexpr size_t WS_XN = 32 * MiB;
constexpr size_t WS_HG = 32 * MiB;
constexpr size_t WS_X1B = 32 * MiB;
constexpr size_t WS_PROJ = 96 * MiB;
constexpr size_t WS_MIX = 320 * MiB;
constexpr size_t WS_ATT = 384 * MiB;
constexpr size_t WS_G = 96 * MiB;
constexpr size_t WS_UL = 272 * MiB, WS_U01 = 275 * MiB, WS_V01 = 278 * MiB;
constexpr size_t WS_DL = 384 * MiB;
constexpr size_t WS_NEED = 512 * MiB;

__device__ __forceinline__ unsigned f2bf(float f) { unsigned u = __float_as_uint(f); return (u + 0x7fffu + ((u >> 16) & 1u)) >> 16; }
__device__ __forceinline__ unsigned pk2(float lo, float hi) { return f2bf(lo) | (f2bf(hi) << 16); }
__device__ __forceinline__ float bf2f(unsigned h) { return __uint_as_float(h << 16); }
#define WS_DPP_ADD(x, ctrl, rmask) x += __int_as_float(__builtin_amdgcn_update_dpp(0, __float_as_int(x), ctrl, rmask, 0xf, true))
__device__ __forceinline__ float wave_sum(float v) {
    WS_DPP_ADD(v, 0x111, 0xf); WS_DPP_ADD(v, 0x112, 0xf); WS_DPP_ADD(v, 0x114, 0xf); WS_DPP_ADD(v, 0x118, 0xf);
    WS_DPP_ADD(v, 0x142, 0xa); WS_DPP_ADD(v, 0x143, 0xc);
    return __int_as_float(__builtin_amdgcn_readlane(__float_as_int(v), 63));
}
template <int N> __device__ __forceinline__ void wave_sum_n(float (&x)[N]) {
#pragma unroll
    for (int i = 0; i < N; ++i) WS_DPP_ADD(x[i], 0x111, 0xf);
#pragma unroll
    for (int i = 0; i < N; ++i) WS_DPP_ADD(x[i], 0x112, 0xf);
#pragma unroll
    for (int i = 0; i < N; ++i) WS_DPP_ADD(x[i], 0x114, 0xf);
#pragma unroll
    for (int i = 0; i < N; ++i) WS_DPP_ADD(x[i], 0x118, 0xf);
#pragma unroll
    for (int i = 0; i < N; ++i) WS_DPP_ADD(x[i], 0x142, 0xa);
#pragma unroll
    for (int i = 0; i < N; ++i) WS_DPP_ADD(x[i], 0x143, 0xc);
#pragma unroll
    for (int i = 0; i < N; ++i) x[i] = __int_as_float(__builtin_amdgcn_readlane(__float_as_int(x[i]), 63));
}
__device__ __forceinline__ float sigmoidf_(float x) { return __builtin_amdgcn_rcpf(1.f + __builtin_amdgcn_exp2f(-1.4426950408889634f * x)); }

struct Args { const float* in[18]; float* out; unsigned char* ws; };

template <int MAPMODE> __device__ __forceinline__ void p0_transpose_item(const float* W, int K, int N, bf16_t* WT, const float* kscale, LAS float* scr, int item, int lane) {
    const int nblk = N / 32, kb = item / nblk, nb = item % nblk, k0 = 64 * kb, n0 = 32 * nb;
    const int orow0 = MAPMODE == 1 ? (((n0 % DFF) >> 7) * 256 + (n0 >= DFF ? 128 : 0) + ((n0 % DFF) & 127))
                    : (MAPMODE == 2 && n0 < 1024) ? ((n0 & ~255) + 128 * ((n0 >> 5) & 1) + 32 * ((n0 & 255) >> 6))
                    : (MAPMODE == 2 && n0 >= 1536 && n0 < 2560) ? ((6 + (((n0 - 1536) & 511) >> 7)) * 256 + (n0 >= 2048 ? 128 : 0) + (n0 & 127)) : n0;
#pragma unroll
    for (int i = 0; i < 8; ++i) { const int kk = 8 * i + (lane >> 3), cc = 4 * (lane & 7);
        f32x4 v = *(const f32x4*)(W + (size_t)(k0 + kk) * N + n0 + cc); if (kscale) v = v * kscale[k0 + kk];
        LAS float* d = scr + kk * 33 + cc; d[0] = v[0]; d[1] = v[1]; d[2] = v[2]; d[3] = v[3]; }
    asm volatile("s_waitcnt lgkmcnt(0)" ::: "memory");
    const int c = lane & 7;
#pragma unroll
    for (int j = 0; j < 4; ++j) { const int n = (lane >> 3) + 8 * j; const LAS float* s = scr + (8 * c) * 33 + n;
        u32x4 o; o.x = pk2(s[0 * 33], s[1 * 33]); o.y = pk2(s[2 * 33], s[3 * 33]); o.z = pk2(s[4 * 33], s[5 * 33]); o.w = pk2(s[6 * 33], s[7 * 33]);
        *(u32x4*)(WT + (size_t)(orow0 + n) * K + k0 + 8 * c) = o; }
    asm volatile("s_waitcnt lgkmcnt(0)" ::: "memory");
}


#define XB_TMO      128
#define XB_XCNT(j)  (256  + 64 * (j))
#define XB_XSUB(j)  (1280 + 64 * (j))
#define XB_XGEN(j)  (2304 + 64 * (j))
#define XB_TOP      3328
#define XB_TOPGEN   3392
#define XCD_BAR_WORDS 3456
#define XB_SPIN_CAP (1u << 18)
__device__ __forceinline__ unsigned xb_ld(unsigned* p)              { return __hip_atomic_load(p, __ATOMIC_RELAXED, __HIP_MEMORY_SCOPE_AGENT); }
__device__ __forceinline__ unsigned xb_add(unsigned* p, unsigned v) { return __hip_atomic_fetch_add(p, v, __ATOMIC_RELAXED, __HIP_MEMORY_SCOPE_AGENT); }
__device__ __forceinline__ unsigned xb_xcc_id() { return (unsigned)__builtin_amdgcn_s_getreg((3 << 11) | 20) & 0xFu; }
#define XB_SPIN(cond, bar) do { unsigned _sp = 0; while (cond) { __builtin_amdgcn_s_sleep(1); \
    if ((++_sp & 255u) == 0u) { if (xb_ld(&(bar)[XB_TMO])) break; if (_sp > XB_SPIN_CAP) { atomicAdd(&(bar)[XB_TMO], 1u); break; } } } } while (0)
struct XcdBarrier { unsigned* bar; unsigned x; volatile LAS unsigned* st; };
__device__ __forceinline__ XcdBarrier xcd_barrier_post(unsigned* bar, volatile LAS unsigned* st) {
    XcdBarrier b; b.bar = bar; b.x = xb_xcc_id(); b.st = st;
    if (threadIdx.x == 0) (void)xb_add(&bar[XB_XCNT(b.x)], 1u);
    return b;
}
__device__ __forceinline__ void xcd_barrier_complete(unsigned* bar, unsigned x, unsigned& nloc, unsigned& nx) {
    const unsigned G = gridDim.x * gridDim.y * gridDim.z;
    unsigned sum, cnt, mine, sp = 0u;
    for (;;) {
        sum = 0u; cnt = 0u; mine = 0u;
#pragma unroll
        for (unsigned j = 0; j < 16; ++j) { const unsigned c = xb_ld(&bar[XB_XCNT(j)]); sum += c; cnt += (c > 0u) ? 1u : 0u; mine = (j == x) ? c : mine; }
        if (sum == G) break;
        __builtin_amdgcn_s_sleep(1);
        if ((++sp & 255u) == 0u) { if (xb_ld(&bar[XB_TMO])) break; if (sp > XB_SPIN_CAP) { atomicAdd(&bar[XB_TMO], 1u); break; } }
    }
    nloc = mine > 0u ? mine : 1u; nx = cnt > 0u ? cnt : 1u;
}
__device__ __forceinline__ void xcd_barrier(const XcdBarrier& b) {
    asm volatile("s_waitcnt vmcnt(0)" ::: "memory");
    __syncthreads();
    if (threadIdx.x == 0) {
        unsigned* bar = b.bar;
        __builtin_amdgcn_s_waitcnt(0);
        unsigned nloc = b.st[0], nx = b.st[1];
        if (nloc == 0u) { xcd_barrier_complete(bar, b.x, nloc, nx); b.st[0] = nloc; b.st[1] = nx; }
        const unsigned old = xb_add(&bar[XB_XSUB(b.x)], 1u);
        const unsigned gen = old / nloc;
        if (old + 1u == (gen + 1u) * nloc) {
            __builtin_amdgcn_fence(__ATOMIC_RELEASE, "agent");
            asm volatile("s_waitcnt vmcnt(0)" ::: "memory");
            const unsigned og = xb_add(&bar[XB_TOP], 1u);
            const unsigned tg = og / nx;
            if (og + 1u == (tg + 1u) * nx) xb_add(&bar[XB_TOPGEN], 1u);
            else XB_SPIN(xb_ld(&bar[XB_TOPGEN]) == tg, bar);
            __builtin_amdgcn_fence(__ATOMIC_ACQUIRE, "agent");
            xb_add(&bar[XB_XGEN(b.x)], 1u);
            asm volatile("s_waitcnt vmcnt(0)" ::: "memory");
        } else {
            XB_SPIN(xb_ld(&bar[XB_XGEN(b.x)]) == gen, bar);
            __builtin_amdgcn_fence(__ATOMIC_ACQUIRE, "agent");
            asm volatile("s_waitcnt vmcnt(0)" ::: "memory");
        }
    }
    __syncthreads();
}
constexpr int CW_BAR = 4096;
constexpr int LDS_MISC = 147456 - 64;

typedef short bf16x8_t __attribute__((ext_vector_type(8)));
typedef short s16x4_t __attribute__((ext_vector_type(4)));
typedef float f32x16 __attribute__((ext_vector_type(16)));
typedef float f32x2_t __attribute__((ext_vector_type(2)));
typedef __bf16 bf16x2_t __attribute__((ext_vector_type(2)));
__device__ __forceinline__ unsigned cvtpk(float lo, float hi) { f32x2_t v = {lo, hi}; bf16x2_t b = __builtin_convertvector(v, bf16x2_t); return __builtin_bit_cast(unsigned, b); }
__device__ __forceinline__ bf16x8_t ld_row8(const LAS unsigned char* p) { return *(const LAS bf16x8_t*)p; }
__device__ __forceinline__ bf16x8_t ld_tr2(const LAS unsigned char* plo, const LAS unsigned char* phi) {
    const s16x4_t lo = __builtin_bit_cast(s16x4_t, __builtin_amdgcn_ds_read_tr16_b64_v4i16((LAS s16x4_t*)plo));
    const s16x4_t hi = __builtin_bit_cast(s16x4_t, __builtin_amdgcn_ds_read_tr16_b64_v4i16((LAS s16x4_t*)phi));
    return (bf16x8_t){lo[0], lo[1], lo[2], lo[3], hi[0], hi[1], hi[2], hi[3]};
}
__device__ __forceinline__ int crow(int r, int h) { return (r & 3) + 8 * (r >> 2) + 4 * h; }
constexpr float LOG2E = 1.4426950408889634f;
constexpr float QSCALE = 0.125f * LOG2E;

namespace fa {
constexpr int SLOT = 32768, NSLOT = 4, KB_ = 0, VB_ = 16384;
constexpr int RB0 = 2 * SLOT, RSRB = 272, RTB = 128 * RSRB;
constexpr int OFF_WL = RB0 + 2 * RTB;
constexpr int OFF_Q = OFF_WL + 1024;
static_assert(OFF_WL >= NSLOT * SLOT && OFF_Q + 16 + 512 <= LDS_MISC, "attention LDS map");
#define FA_SB() __builtin_amdgcn_sched_barrier(0)

__device__ __forceinline__ int attn_run(LAS unsigned char* lds, const bf16_t* __restrict__ PROJ, bf16_t* __restrict__ MIX, const float* __restrict__ sublnw, unsigned* ctl,
                                        float lam, int tid, int lane, int wave) {
    const int r32 = lane & 31, hi = lane >> 5, rb = wave & 3, c = wave >> 2;
    LAS int* qslot = (LAS int*)(lds + OFF_Q);
    LAS float* swl = (LAS float*)(lds + OFF_Q + 16);
    if (tid < 128) swl[tid] = sublnw[tid];
    int kof[4], vof[4];
    const int g4 = lane >> 4, i16 = lane & 15, q4 = i16 >> 2, p4 = i16 & 3;
#pragma unroll
    for (int d0 = 0; d0 < 4; ++d0) kof[d0] = KB_ + r32 * 256 + (((c * 8 + 2 * d0 + hi) ^ (r32 & 15)) << 4);
#pragma unroll
    for (int eb = 0; eb < 4; ++eb) vof[eb] = VB_ + (4 * hi + q4) * 256 + ((4 * (eb ^ q4) + 2 * (g4 & 1) + (p4 >> 1)) << 4) + 8 * (p4 & 1);
    size_t goff[4];
#pragma unroll
    for (int i = 0; i < 2; ++i) {
        const int row = 8 * wave + 4 * i + (lane >> 4), pc = lane & 15;
        goff[i]     = (size_t)row * NCOLS + OFF_DK + ((pc ^ (row & 15)) << 3);
        goff[2 + i] = (size_t)row * NCOLS + OFF_DV + ((pc ^ ((row & 3) << 2)) << 3);
    }
#define FA_DMA(gbase, t, slot) do { const bf16_t* g_ = (gbase) + (size_t)(t) * 64 * NCOLS; LAS unsigned char* d_ = lds + (slot) * SLOT + wave * 2048; \
        __builtin_amdgcn_global_load_lds((const unsigned*)(g_ + goff[0]), (LAS unsigned*)(d_ + KB_), 16, 0, 0); \
        __builtin_amdgcn_global_load_lds((const unsigned*)(g_ + goff[1]), (LAS unsigned*)(d_ + KB_ + 1024), 16, 0, 0); \
        __builtin_amdgcn_global_load_lds((const unsigned*)(g_ + goff[2]), (LAS unsigned*)(d_ + VB_), 16, 0, 0); \
        __builtin_amdgcn_global_load_lds((const unsigned*)(g_ + goff[3]), (LAS unsigned*)(d_ + VB_ + 1024), 16, 0, 0); } while (0)
#define FA_DMA1(gbase, t, slot, i) __builtin_amdgcn_global_load_lds((const unsigned*)((gbase) + (size_t)(t) * 64 * NCOLS + goff[i]), \
        (LAS unsigned*)(lds + (slot) * SLOT + wave * 2048 + ((i) >> 1) * VB_ + ((i) & 1) * 1024), 16, 0, 0)
#define FA_PREFETCH(uu, qdst) do { const int b_ = ((uu) & 63) >> 2, h_ = (uu) & 3, qb_ = 15 - ((uu) >> 6); \
        const bf16_t* qp_ = PROJ + ((size_t)b_ * S + qb_ * 128 + rb * 32 + r32) * NCOLS + OFF_DQ + h_ * 128 + c * 64 + hi * 8; \
        _Pragma("unroll") for (int d0 = 0; d0 < 4; ++d0) qdst[d0] = *(const bf16x8_t*)(qp_ + d0 * 16); \
        const bf16_t* gb_ = PROJ + (size_t)b_ * S * NCOLS + h_ * 128; FA_DMA(gb_, 0, 0); FA_DMA(gb_, 1, 1); } while (0)
    if (tid == 0) *qslot = (int)__hip_atomic_fetch_add(ctl, 1u, __ATOMIC_RELAXED, __HIP_MEMORY_SCOPE_AGENT);
    __syncthreads();
    int u = __builtin_amdgcn_readfirstlane(*qslot);
    __syncthreads();
    if (u >= 1024) return u;
    bf16x8_t qr[4], qn[4];
    FA_PREFETCH(u, qr);
    for (;;) {
        if (tid == 0) *qslot = (int)__hip_atomic_fetch_add(ctl, 1u, __ATOMIC_RELAXED, __HIP_MEMORY_SCOPE_AGENT);
        const int b = (u & 63) >> 2, h = u & 3, qb = 15 - (u >> 6);
        const size_t rowbase = (size_t)b * S;
        const bf16_t* gbase = PROJ + rowbase * NCOLS + h * 128;
        const int NT = 2 * qb + 2, cw = 2 * qb + (rb >> 1);
        f32x16 o[4];
#pragma unroll
        for (int e = 0; e < 4; ++e)
#pragma unroll
            for (int r = 0; r < 16; ++r) o[e][r] = 0.f;
        float lsum = 0.f;
        f32x16 C[2];
        const f32x16 fzero = {0.f, 0.f, 0.f, 0.f, 0.f, 0.f, 0.f, 0.f, 0.f, 0.f, 0.f, 0.f, 0.f, 0.f, 0.f, 0.f};
        unsigned pw[16], pwn[16];
#pragma unroll
        for (int i = 0; i < 16; ++i) { pw[i] = 0u; pwn[i] = 0u; }
#define FA_VFRAG(slB, j) ld_tr2((slB) + vof[(j) & 3] + (((j) >> 2) * 16) * 256, (slB) + vof[(j) & 3] + (((j) >> 2) * 16 + 8) * 256)
#define FA_PW(ks) __builtin_bit_cast(bf16x8_t, (u32x4){pw[4 * (ks)], pw[4 * (ks) + 1], pw[4 * (ks) + 2], pw[4 * (ks) + 3]})
#define FA_STEP(DO_A, DO_B, slA, slB, masked, dma_on, dma_t, dma_slot) do { \
            bf16x8_t vf[16]; bf16x8_t ka[4], kb2[4]; \
            if (DO_A) { ka[0] = ld_row8((slA) + kof[0]); kb2[0] = ld_row8((slA) + kof[0] + 8192); \
                        ka[1] = ld_row8((slA) + kof[1]); kb2[1] = ld_row8((slA) + kof[1] + 8192); \
                if (masked) { _Pragma("unroll") for (int r = 0; r < 16; ++r) { C[0][r] = -1.0e30f; C[1][r] = -1.0e30f; } \
                    C[0] = __builtin_amdgcn_mfma_f32_32x32x16_bf16(ka[0], qr[0], C[0], 0, 0, 0); FA_SB(); C[1] = __builtin_amdgcn_mfma_f32_32x32x16_bf16(kb2[0], qr[0], C[1], 0, 0, 0); FA_SB(); } \
                else { C[0] = __builtin_amdgcn_mfma_f32_32x32x16_bf16(ka[0], qr[0], fzero, 0, 0, 0); FA_SB(); C[1] = __builtin_amdgcn_mfma_f32_32x32x16_bf16(kb2[0], qr[0], fzero, 0, 0, 0); FA_SB(); } } \
            _Pragma("unroll") for (int d0 = 1; d0 < 4; ++d0) { \
                if (DO_A && d0 < 3) { ka[d0 + 1] = ld_row8((slA) + kof[d0 + 1]); kb2[d0 + 1] = ld_row8((slA) + kof[d0 + 1] + 8192); } \
                if (DO_A) C[0] = __builtin_amdgcn_mfma_f32_32x32x16_bf16(ka[d0], qr[d0], C[0], 0, 0, 0); \
                if (DO_B && 2 * d0 >= 4) vf[2 * d0 - 4] = FA_VFRAG(slB, 2 * d0 - 4); \
                if (DO_B && d0 == 3) vf[4] = FA_VFRAG(slB, 4); \
                FA_SB(); \
                if (DO_A) C[1] = __builtin_amdgcn_mfma_f32_32x32x16_bf16(kb2[d0], qr[d0], C[1], 0, 0, 0); \
                if (DO_B && 2 * d0 + 1 >= 4) vf[2 * d0 - 3] = FA_VFRAG(slB, 2 * d0 - 3); \
                if (DO_A) { if (dma_on) { FA_DMA1(gbase, dma_t, dma_slot, d0); if (d0 == 1) FA_DMA1(gbase, dma_t, dma_slot, 0); } } \
                FA_SB(); } \
            if (DO_B && !(DO_A)) { _Pragma("unroll") for (int j = 0; j < 5; ++j) vf[j] = FA_VFRAG(slB, j); } \
            _Pragma("unroll") for (int j = 0; j < 16; ++j) { \
                if (DO_B) o[j & 3] = __builtin_amdgcn_mfma_f32_32x32x16_bf16(FA_PW(j >> 2), vf[j], o[j & 3], 0, 0, 0); \
                if (DO_B && j + 5 < 16) vf[j + 5] = FA_VFRAG(slB, j + 5); \
                if (DO_A) { C[(2 * j) >> 4][(2 * j) & 15] = __builtin_amdgcn_exp2f(C[(2 * j) >> 4][(2 * j) & 15]); C[(2 * j + 1) >> 4][(2 * j + 1) & 15] = __builtin_amdgcn_exp2f(C[(2 * j + 1) >> 4][(2 * j + 1) & 15]); \
                    if (j >= 1) { const float a_ = C[(2 * j - 2) >> 4][(2 * j - 2) & 15], b_ = C[(2 * j - 1) >> 4][(2 * j - 1) & 15]; pwn[j - 1] = cvtpk(a_, b_); lsum += a_; lsum += b_; } } \
                FA_SB(); } \
            if (DO_A) { const float a_ = C[1][14], b_ = C[1][15]; pwn[15] = cvtpk(a_, b_); lsum += a_; lsum += b_; } \
            _Pragma("unroll") for (int i = 0; i < 16; ++i) pw[i] = pwn[i]; \
            FA_SB(); } while (0)
        asm volatile("s_waitcnt vmcnt(4)" ::: "memory");
        asm volatile("s_waitcnt lgkmcnt(0)" ::: "memory"); __builtin_amdgcn_s_barrier(); asm volatile("" ::: "memory");
        FA_STEP(true, false, lds, lds, false, 2 < NT, 2, 2);
        int slot = 1;
        for (int t = 1; t < NT; ++t) {
            if (t + 1 < NT) asm volatile("s_waitcnt vmcnt(4)" ::: "memory"); else asm volatile("s_waitcnt vmcnt(0)" ::: "memory");
            asm volatile("s_waitcnt lgkmcnt(0)" ::: "memory"); __builtin_amdgcn_s_barrier(); asm volatile("" ::: "memory");
            const LAS unsigned char* slA = lds + slot * SLOT; const LAS unsigned char* slB = lds + ((slot + 3) & 3) * SLOT;
            FA_STEP(true, true, slA, slB, t > cw, t + 2 < NT, t + 2, (slot + 2) & 3);
            slot = (slot + 1) & 3;
        }
        { const LAS unsigned char* slB = lds + ((slot + 3) & 3) * SLOT; FA_STEP(false, true, slB, slB, false, false, 0, 0); }
        asm volatile("s_waitcnt lgkmcnt(0)" ::: "memory"); __builtin_amdgcn_s_barrier(); asm volatile("" ::: "memory");
        const int un = __builtin_amdgcn_readfirstlane(*qslot);
        if (un < 1024) FA_PREFETCH(un, qn);
        lsum += __shfl_xor(lsum, 32);
        LAS float* wl = (LAS float*)(lds + OFF_WL) + wave * 32;
        if (hi == 0) wl[r32] = lsum;
        asm volatile("s_waitcnt lgkmcnt(0)" ::: "memory");
        {
            LAS unsigned char* R = lds + RB0 + c * RTB + (rb * 32) * RSRB + r32 * 2;
#pragma unroll
            for (int r = 0; r < 16; ++r) {
                const float rl = (c ? lam : 1.f) * __builtin_amdgcn_rcpf(wl[crow(r, hi)]);
#pragma unroll
                for (int eb = 0; eb < 4; ++eb) *(LAS unsigned short*)(R + crow(r, hi) * RSRB + eb * 64) = (unsigned short)cvtpk(o[eb][r] * rl, 0.f);
            }
        }
        asm volatile("s_waitcnt lgkmcnt(0)" ::: "memory"); __builtin_amdgcn_s_barrier(); asm volatile("" ::: "memory");
        for (int it = 0; it < 2; ++it) {
            const int row = wave * 16 + it * 8 + (lane >> 3), sg = lane & 7;
            const LAS unsigned char* rp = lds + RB0 + row * RSRB + sg * 32;
            const u32x4 a0 = *(const LAS u32x4*)rp, a1 = *(const LAS u32x4*)(rp + 16), b0 = *(const LAS u32x4*)(rp + RTB), b1 = *(const LAS u32x4*)(rp + RTB + 16);
            const f32x4 w0 = *(const LAS f32x4*)(swl + sg * 16), w1 = *(const LAS f32x4*)(swl + sg * 16 + 4), w2 = *(const LAS f32x4*)(swl + sg * 16 + 8), w3 = *(const LAS f32x4*)(swl + sg * 16 + 12);
            float dv[16];
#pragma unroll
            for (int i = 0; i < 4; ++i) {
                dv[2 * i]     = __uint_as_float(a0[i] << 16) - __uint_as_float(b0[i] << 16);         dv[2 * i + 1] = __uint_as_float(a0[i] & 0xffff0000u) - __uint_as_float(b0[i] & 0xffff0000u);
                dv[8 + 2 * i] = __uint_as_float(a1[i] << 16) - __uint_as_float(b1[i] << 16);     dv[8 + 2 * i + 1] = __uint_as_float(a1[i] & 0xffff0000u) - __uint_as_float(b1[i] & 0xffff0000u);
            }
            float ss = 0.f;
#pragma unroll
            for (int i = 0; i < 16; i += 4) ss += (dv[i] * dv[i] + dv[i + 1] * dv[i + 1]) + (dv[i + 2] * dv[i + 2] + dv[i + 3] * dv[i + 3]);
            ss += __int_as_float(__builtin_amdgcn_update_dpp(0, __float_as_int(ss), 0xB1, 0xf, 0xf, true));
            ss += __int_as_float(__builtin_amdgcn_update_dpp(0, __float_as_int(ss), 0x4E, 0xf, 0xf, true));
            ss += __int_as_float(__builtin_amdgcn_update_dpp(0, __float_as_int(ss), 0x141, 0xf, 0xf, true));
            const float rr = rsqrtf(ss * (1.f / 128.f) + EPS) * (1.f - LAM_INIT);
            u32x4 o0, o1;
#pragma unroll
            for (int i = 0; i < 2; ++i) {
                o0[i]     = cvtpk(dv[2 * i] * rr * w0[2 * i], dv[2 * i + 1] * rr * w0[2 * i + 1]);
                o0[2 + i] = cvtpk(dv[4 + 2 * i] * rr * w1[2 * i], dv[4 + 2 * i + 1] * rr * w1[2 * i + 1]);
                o1[i]     = cvtpk(dv[8 + 2 * i] * rr * w2[2 * i], dv[8 + 2 * i + 1] * rr * w2[2 * i + 1]);
                o1[2 + i] = cvtpk(dv[12 + 2 * i] * rr * w3[2 * i], dv[12 + 2 * i + 1] * rr * w3[2 * i + 1]);
            }
            bf16_t* op = MIX + (rowbase + qb * 128 + row) * D + h * 128 + sg * 16;
            *(u32x4*)op = o0; *(u32x4*)(op + 8) = o1;
        }
        asm volatile("s_waitcnt vmcnt(0)" ::: "memory");
        asm volatile("s_waitcnt lgkmcnt(0)" ::: "memory"); __builtin_amdgcn_s_barrier(); asm volatile("" ::: "memory");
        if (un >= 1024) return un;
        u = un;
#pragma unroll
        for (int d0 = 0; d0 < 4; ++d0) qr[d0] = qn[d0];
    }
#undef FA_STEP
#undef FA_PW
#undef FA_VFRAG
#undef FA_DMA
#undef FA_DMA1
#undef FA_PREFETCH
}
#undef FA_SB
}


namespace hg {
constexpr int RSQ = 272, RSKR = 272, RSKC = 320, RSV = 320, RSA = 144, RSS = 272, RSR = 132;
constexpr int OFF_QT = 0;
constexpr int OFF_KR = OFF_QT + 64 * RSQ;
constexpr int OFF_KC = OFF_KR + 64 * RSKR;
constexpr int OFF_VT = OFF_KC + 64 * RSKC;
constexpr int OFF_AM = OFF_VT + 64 * RSV;
constexpr int OFF_ST = OFF_AM + 64 * RSA;
constexpr int OFF_BL = OFF_ST + 128 * RSS;
constexpr int OFF_GT = OFF_BL + 512;
constexpr int OFF_R = OFF_KR;
static_assert(OFF_GT + 64 * 256 <= LDS_MISC && 64 * RSR * 4 <= 64 * RSKR + 64 * RSKC, "hgrn LDS map");


#define HG_DPP_ADD(x, ctrl) x += __int_as_float(__builtin_amdgcn_update_dpp(0, __float_as_int(x), ctrl, 0xf, 0xf, true))
__device__ __forceinline__ void hgrn_pre_wave(bf16_t* PROJ, const float* __restrict__ lbl, float* __restrict__ DL, int b0, int h, int ch, int c4, int lane) {
    const int tr = lane & 15, cc = lane >> 4, col = h * 128 + 32 * c4 + 8 * cc;
    float lbv[8];
#pragma unroll
    for (int j = 0; j < 8; ++j) { const float l0 = lbl[col + j], l1 = lbl[512 + col + j]; lbv[j] = __builtin_amdgcn_rcpf(1.f + __builtin_amdgcn_exp2f((l1 - l0) * 1.4426950408889634f)); }
    bf16_t* gq = PROJ + ((size_t)b0 * S + ch * 64 + 4 * tr) * NCOLS + OFF_HQ + col;
    bf16_t* gf = PROJ + ((size_t)b0 * S + ch * 64 + 4 * tr) * NCOLS + OFF_HF + col;
    u32x4 nq[4], nf[4];
#pragma unroll
    for (int m = 0; m < 4; ++m) { nq[m] = *(const u32x4*)(gq + m * NCOLS); nf[m] = *(const u32x4*)(gf + m * NCOLS); }
    for (int k = 0; k < NB / 4; ++k) {
        u32x4 wq[4], wf[4];
#pragma unroll
        for (int m = 0; m < 4; ++m) { wq[m] = nq[m]; wf[m] = nf[m]; }
        bf16_t* cq = gq; bf16_t* cf = gf;
        if (k + 1 < NB / 4) { gq += (size_t)4 * S * NCOLS; gf += (size_t)4 * S * NCOLS;
#pragma unroll
            for (int m = 0; m < 4; ++m) { nq[m] = *(const u32x4*)(gq + m * NCOLS); nf[m] = *(const u32x4*)(gf + m * NCOLS); } }
        float bc[4][8], omf[4][8];
#pragma unroll
        for (int m = 0; m < 4; ++m)
#pragma unroll
            for (int j = 0; j < 8; ++j) {
                const unsigned w = wf[m][j >> 1];
                const float z = bf2f((j & 1) ? (w >> 16) : (w & 0xffffu));
                const float f = lbv[j] + (1.f - lbv[j]) * sigmoidf_(z);
                omf[m][j] = 1.f - f; bc[m][j] = __builtin_amdgcn_logf(f) + (m ? bc[m - 1][j] : 0.f);
            }
#pragma unroll
        for (int j = 0; j < 8; ++j) {
            float tot = bc[3][j];
            HG_DPP_ADD(tot, 0x111); HG_DPP_ADD(tot, 0x112); HG_DPP_ADD(tot, 0x114); HG_DPP_ADD(tot, 0x118);
            const float carry = tot - bc[3][j];
#pragma unroll
            for (int m = 0; m < 4; ++m) bc[m][j] += carry;
        }
#pragma unroll
        for (int m = 0; m < 4; ++m) {
            unsigned oq[4], ok[4];
#pragma unroll
            for (int i = 0; i < 4; ++i) {
                const float q0 = bf2f(wq[m][i] & 0xffffu), q1 = bf2f(wq[m][i] >> 16);
                const float e0 = __builtin_amdgcn_exp2f(bc[m][2 * i]), e1 = __builtin_amdgcn_exp2f(bc[m][2 * i + 1]), n0 = __builtin_amdgcn_exp2f(-bc[m][2 * i]), n1 = __builtin_amdgcn_exp2f(-bc[m][2 * i + 1]);
                oq[i] = cvtpk(q0 * e0, q1 * e1); ok[i] = cvtpk(omf[m][2 * i] * n0, omf[m][2 * i + 1] * n1);
            }
            *(u32x4*)(cq + m * NCOLS) = (u32x4){oq[0], oq[1], oq[2], oq[3]};
            *(u32x4*)(cf + m * NCOLS) = (u32x4){ok[0], ok[1], ok[2], ok[3]};
        }
        if (tr == 15) {
            float* dp = DL + (size_t)(((b0 + 4 * k) * 4 + h) * 32 + ch) * 128 + 32 * c4 + 8 * cc;
            *(f32x4*)dp = (f32x4){__builtin_amdgcn_exp2f(bc[3][0]), __builtin_amdgcn_exp2f(bc[3][1]), __builtin_amdgcn_exp2f(bc[3][2]), __builtin_amdgcn_exp2f(bc[3][3])};
            *(f32x4*)(dp + 4) = (f32x4){__builtin_amdgcn_exp2f(bc[3][4]), __builtin_amdgcn_exp2f(bc[3][5]), __builtin_amdgcn_exp2f(bc[3][6]), __builtin_amdgcn_exp2f(bc[3][7])};
        }
    }
}
#undef HG_DPP_ADD

__device__ __forceinline__ void hgrn_unit(LAS unsigned char* lds, const bf16_t* __restrict__ PROJ, bf16_t* __restrict__ MIX, const float* __restrict__ DL, const float* __restrict__ hnw,
                                          int b, int h, int tid, int lane, int wave) {
    const int r32 = lane & 31, hi = lane >> 5, g4 = lane >> 4, i16 = lane & 15;
    const size_t rowbase = (size_t)b * S;
    f32x16 sreg[2];
#pragma unroll
    for (int j = 0; j < 2; ++j)
#pragma unroll
        for (int r = 0; r < 16; ++r) sreg[j][r] = 0.f;
    for (int i = tid; i < 128 * RSS / 16; i += NTHREADS) *(LAS u32x4*)(lds + OFF_ST + i * 16) = (u32x4){0u, 0u, 0u, 0u};
    const int vb = wave & 3, kb0 = 2 * (wave >> 2), tb = wave >> 2;
    const int trb = (8 * hi + (i16 >> 2)) * 320 + (16 * (g4 & 1) + 4 * (i16 & 3)) * 2;
    const int rrb = r32 * 272 + hi * 16;
    const int half = wave >> 2, st = tid & 255, srow = st >> 4, sch = st & 15;
    const bf16_t* gq = PROJ + (rowbase + srow) * NCOLS + OFF_HQ + h * 128 + sch * 8;
    const bf16_t* gf = PROJ + (rowbase + srow) * NCOLS + OFF_HF + h * 128 + sch * 8;
    const bf16_t* gi = PROJ + (rowbase + srow) * NCOLS + OFF_HI + h * 128 + sch * 8;
    const bf16_t* gg = PROJ + (rowbase + srow) * NCOLS + OFF_HG + h * 128 + sch * 8;
    const float* gd = DL + (size_t)((b * 4 + h) * 32) * 128 + (st & 31) * 4;
    u32x4 nq[4], nf[4], nv[4], ng[4]; f32x4 nd = (f32x4){0.f, 0.f, 0.f, 0.f};
#define HG_LD16(dst, ptr) asm volatile("global_load_dwordx4 %0, %1, off" : "=v"(dst) : "v"(ptr) : "memory")
#define HG_LOAD(chn) do { const size_t o_ = (size_t)(chn) * 64 * NCOLS; \
        _Pragma("unroll") for (int i = 0; i < 4; ++i) { HG_LD16(nq[i], gq + o_ + i * 16 * NCOLS); HG_LD16(nf[i], gf + o_ + i * 16 * NCOLS); HG_LD16(nv[i], gi + o_ + i * 16 * NCOLS); HG_LD16(ng[i], gg + o_ + i * 16 * NCOLS); } \
        HG_LD16(nd, gd + (chn) * 128); } while (0)
#define HG_TIES "+v"(nq[0]), "+v"(nq[1]), "+v"(nq[2]), "+v"(nq[3]), "+v"(nf[0]), "+v"(nf[1]), "+v"(nf[2]), "+v"(nf[3]), "+v"(nv[0]), "+v"(nv[1]), "+v"(nv[2]), "+v"(nv[3]), \
                "+v"(ng[0]), "+v"(ng[1]), "+v"(ng[2]), "+v"(ng[3]), "+v"(nd)
    HG_LOAD(half);
    {
        const u32x4 zero_ = (u32x4){0u, 0u, 0u, 0u};
        bf16_t* op = MIX + (rowbase + wave * 8 + (lane >> 3)) * D + 512 + h * 128 + (lane & 7) * 16;
        asm volatile("global_store_dwordx4 %0, %1, off\n\ts_nop 1" :: "v"(op), "v"(zero_) : "memory");
        asm volatile("global_store_dwordx4 %0, %1, off\n\ts_nop 1" :: "v"(op + 8), "v"(zero_) : "memory");
        if (half == 0) {
            asm volatile("global_store_dwordx4 %0, %1, off\n\ts_nop 1" :: "v"(op), "v"(zero_) : "memory");
            asm volatile("global_store_dwordx4 %0, %1, off\n\ts_nop 1" :: "v"(op + 8), "v"(zero_) : "memory");
        }
    }
    for (int ch = 0; ch < S / 64; ++ch) {
        if (half == (ch & 1)) {
            asm volatile("s_waitcnt vmcnt(4)" : HG_TIES :: "memory");
#pragma unroll
            for (int i = 0; i < 4; ++i) {
                *(LAS u32x4*)(lds + OFF_QT + (srow + 16 * i) * RSQ + sch * 16) = nq[i];
                *(LAS u32x4*)(lds + OFF_KR + (srow + 16 * i) * RSKR + sch * 16) = nf[i];
                *(LAS u32x4*)(lds + OFF_KC + (srow + 16 * i) * RSKC + sch * 16) = nf[i];
                *(LAS u32x4*)(lds + OFF_VT + (srow + 16 * i) * RSV + sch * 16) = nv[i];
                *(LAS u32x4*)(lds + OFF_GT + (srow + 16 * i) * 256 + sch * 16) = ng[i];
            }
            if (st < 32) *(LAS f32x4*)(lds + OFF_BL + st * 16) = nd;
            if (ch + 2 < S / 64) HG_LOAD(ch + 2);
        }
        __syncthreads();
        {
            const LAS unsigned char* ka = lds + OFF_KC + trb + kb0 * 64;
            const LAS unsigned char* va = lds + OFF_VT + trb + vb * 64;
            bf16x8_t wb[4], wa0[4], wa1[4];
#define HG_WLD(i) do { wb[i] = ld_tr2(va + (i) * 16 * 320, va + (i) * 16 * 320 + 4 * 320); wa0[i] = ld_tr2(ka + (i) * 16 * 320, ka + (i) * 16 * 320 + 4 * 320); \
                       wa1[i] = ld_tr2(ka + 64 + (i) * 16 * 320, ka + 64 + (i) * 16 * 320 + 4 * 320); } while (0)
#define HG_WMM(i) do { sreg[0] = __builtin_amdgcn_mfma_f32_32x32x16_bf16(wa0[i], wb[i], sreg[0], 0, 0, 0); sreg[1] = __builtin_amdgcn_mfma_f32_32x32x16_bf16(wa1[i], wb[i], sreg[1], 0, 0, 0); } while (0)
            HG_WLD(0); HG_WLD(1);
            if (wave < 3) {
                const int sb = wave >> 1, tbb = (wave + 1) >> 1;
                const LAS unsigned char* kr = lds + OFF_KR + rrb + sb * 32 * RSKR;
                const LAS unsigned char* qr_ = lds + OFF_QT + rrb + tbb * 32 * RSQ;
                bf16x8_t xk[8], xq[8];
                __builtin_amdgcn_sched_barrier(0);
                HG_WMM(0); HG_WLD(2);
#pragma unroll
                for (int k = 0; k < 2; ++k) { xk[k] = ld_row8(kr + k * 32); xq[k] = ld_row8(qr_ + k * 32); }
                __builtin_amdgcn_sched_barrier(0);
                HG_WMM(1); HG_WLD(3);
#pragma unroll
                for (int k = 2; k < 4; ++k) { xk[k] = ld_row8(kr + k * 32); xq[k] = ld_row8(qr_ + k * 32); }
                __builtin_amdgcn_sched_barrier(0);
                HG_WMM(2);
#pragma unroll
                for (int k = 4; k < 6; ++k) { xk[k] = ld_row8(kr + k * 32); xq[k] = ld_row8(qr_ + k * 32); }
                __builtin_amdgcn_sched_barrier(0);
                HG_WMM(3);
#pragma unroll
                for (int k = 6; k < 8; ++k) { xk[k] = ld_row8(kr + k * 32); xq[k] = ld_row8(qr_ + k * 32); }
                __builtin_amdgcn_sched_barrier(0);
                f32x16 acc;
#pragma unroll
                for (int r = 0; r < 16; ++r) acc[r] = 0.f;
#pragma unroll
                for (int k = 0; k < 8; ++k) acc = __builtin_amdgcn_mfma_f32_32x32x16_bf16(xk[k], xq[k], acc, 0, 0, 0);
                if (sb == tbb) {
#pragma unroll
                    for (int r = 0; r < 16; ++r) if (crow(r, hi) > r32) acc[r] = 0.f;
                }
                LAS unsigned char* am = lds + OFF_AM + (32 * tbb + r32) * RSA + (32 * sb + 4 * hi) * 2;
#pragma unroll
                for (int g = 0; g < 4; ++g) *(LAS u32x2*)(am + 16 * g) = (u32x2){cvtpk(acc[4 * g], acc[4 * g + 1]), cvtpk(acc[4 * g + 2], acc[4 * g + 3])};
            } else {
                __builtin_amdgcn_sched_barrier(0);
                HG_WMM(0); HG_WLD(2);
                __builtin_amdgcn_sched_barrier(0);
                HG_WMM(1); HG_WLD(3);
                __builtin_amdgcn_sched_barrier(0);
                HG_WMM(2); HG_WMM(3);
            }
#undef HG_WLD
#undef HG_WMM
            const LAS float* bl = (const LAS float*)(lds + OFF_BL);
#pragma unroll
            for (int j = 0; j < 2; ++j)
#pragma unroll
                for (int g = 0; g < 4; ++g) {
                    const f32x4 bv = *(const LAS f32x4*)(bl + 32 * (kb0 + j) + 8 * g + 4 * hi);
                    sreg[j][4 * g] *= bv[0]; sreg[j][4 * g + 1] *= bv[1]; sreg[j][4 * g + 2] *= bv[2]; sreg[j][4 * g + 3] *= bv[3];
                }
        }
        __syncthreads();
        {
            f32x16 acc;
#pragma unroll
            for (int r = 0; r < 16; ++r) acc[r] = 0.f;
            const LAS unsigned char* amr = lds + OFF_AM + (32 * tb + r32) * RSA + hi * 16;
            const LAS unsigned char* va = lds + OFF_VT + trb + vb * 64;
            const LAS unsigned char* qr_ = lds + OFF_QT + rrb + tb * 32 * RSQ;
            const LAS unsigned char* sr_ = lds + OFF_ST + rrb + vb * 32 * RSS;
            bf16x8_t ya[4], yv[4], yq[8], ys[8];
#pragma unroll
            for (int i = 0; i < 2; ++i) { ya[i] = ld_row8(amr + i * 32); yv[i] = ld_tr2(va + i * 16 * 320, va + i * 16 * 320 + 4 * 320); }
            if (tb) {
#pragma unroll
                for (int i = 2; i < 4; ++i) { ya[i] = ld_row8(amr + i * 32); yv[i] = ld_tr2(va + i * 16 * 320, va + i * 16 * 320 + 4 * 320); }
            }
#pragma unroll
            for (int k = 0; k < 4; ++k) { yq[k] = ld_row8(qr_ + k * 32); ys[k] = ld_row8(sr_ + k * 32); }
            __builtin_amdgcn_sched_barrier(0);
#pragma unroll
            for (int i = 0; i < 2; ++i) acc = __builtin_amdgcn_mfma_f32_32x32x16_bf16(ya[i], yv[i], acc, 0, 0, 0);
            if (tb) {
#pragma unroll
                for (int i = 2; i < 4; ++i) acc = __builtin_amdgcn_mfma_f32_32x32x16_bf16(ya[i], yv[i], acc, 0, 0, 0);
            }
#pragma unroll
            for (int k = 4; k < 8; ++k) { yq[k] = ld_row8(qr_ + k * 32); ys[k] = ld_row8(sr_ + k * 32); }
            __builtin_amdgcn_sched_barrier(0);
#pragma unroll
            for (int k = 0; k < 8; ++k) acc = __builtin_amdgcn_mfma_f32_32x32x16_bf16(yq[k], ys[k], acc, 0, 0, 0);
            LAS float* R = (LAS float*)(lds + OFF_R) + vb * 32 + r32;
#pragma unroll
            for (int r = 0; r < 16; ++r) R[(32 * tb + crow(r, hi)) * RSR] = acc[r];
        }
        __syncthreads();
        {
#pragma unroll
            for (int j = 0; j < 2; ++j) {
                LAS unsigned char* sp = lds + OFF_ST + (32 * vb + r32) * RSS + (32 * (kb0 + j) + 4 * hi) * 2;
#pragma unroll
                for (int g = 0; g < 4; ++g) *(LAS u32x2*)(sp + 16 * g) = (u32x2){cvtpk(sreg[j][4 * g], sreg[j][4 * g + 1]), cvtpk(sreg[j][4 * g + 2], sreg[j][4 * g + 3])};
            }
            {
                const int rw = lane >> 3, sg = lane & 7, t = wave * 8 + rw;
                const LAS float* rp = (const LAS float*)(lds + OFF_R) + t * RSR + sg * 16;
                const f32x4 r0 = *(const LAS f32x4*)rp, r1 = *(const LAS f32x4*)(rp + 4), r2 = *(const LAS f32x4*)(rp + 8), r3 = *(const LAS f32x4*)(rp + 12);
                const u32x4 g0 = *(const LAS u32x4*)(lds + OFF_GT + t * 256 + sg * 32), g1 = *(const LAS u32x4*)(lds + OFF_GT + t * 256 + sg * 32 + 16);
                float ss = 0.f;
#pragma unroll
                for (int i = 0; i < 4; ++i) ss += (r0[i] * r0[i] + r1[i] * r1[i]) + (r2[i] * r2[i] + r3[i] * r3[i]);
                ss += __int_as_float(__builtin_amdgcn_update_dpp(0, __float_as_int(ss), 0xB1, 0xf, 0xf, true));
                ss += __int_as_float(__builtin_amdgcn_update_dpp(0, __float_as_int(ss), 0x4E, 0xf, 0xf, true));
                ss += __int_as_float(__builtin_amdgcn_update_dpp(0, __float_as_int(ss), 0x141, 0xf, 0xf, true));
                const float rr = rsqrtf(ss * (1.f / 128.f) + EPS);
#define HG_PK(rv, gw, j) cvtpk(rv[2 * (j)] * rr * __uint_as_float(gw << 16), rv[2 * (j) + 1] * rr * __uint_as_float(gw & 0xffff0000u))
                const u32x4 o0 = (u32x4){HG_PK(r0, g0[0], 0), HG_PK(r0, g0[1], 1), HG_PK(r1, g0[2], 0), HG_PK(r1, g0[3], 1)};
                const u32x4 o1 = (u32x4){HG_PK(r2, g1[0], 0), HG_PK(r2, g1[1], 1), HG_PK(r3, g1[2], 0), HG_PK(r3, g1[3], 1)};
#undef HG_PK
                bf16_t* op = MIX + (rowbase + ch * 64 + t) * D + 512 + h * 128 + sg * 16;
                asm volatile("global_store_dwordx4 %0, %1, off\n\ts_nop 1" :: "v"(op), "v"(o0) : "memory");
                asm volatile("global_store_dwordx4 %0, %1, off\n\ts_nop 1" :: "v"(op + 8), "v"(o1) : "memory");
            }
        }
        __syncthreads();
    }
#undef HG_LOAD
#undef HG_LD16
#undef HG_TIES
}
}

__global__ void __launch_bounds__(NTHREADS, 2) mega_fwd(Args args) {
    extern __shared__ __attribute__((aligned(16))) unsigned char lds_raw[];
    cg::grid_group grid = cg::this_grid();
    LAS unsigned char* lds = (LAS unsigned char*)lds_raw;
    const int tid = threadIdx.x, lane = tid & 63, wave = __builtin_amdgcn_readfirstlane(tid >> 6);
    const int G = gridDim.x, gw = blockIdx.x * NWAVES + wave, NGW = G * NWAVES;
    const float* x = args.in[0]; const float* ln1w = args.in[1]; const float* w_in = args.in[2];
    const float* qnw = args.in[3]; const float* knw = args.in[4];
    const float* lq1 = args.in[5]; const float* lk1 = args.in[6]; const float* lq2 = args.in[7]; const float* lk2 = args.in[8];
    const float* sublnw = args.in[9]; const float* lbl = args.in[10]; const float* hnw = args.in[11];
    const float* w_out = args.in[12]; const float* ln2w = args.in[13]; const float* w_up = args.in[14];
    const float* cw = args.in[15]; const float* cb = args.in[16]; const float* w_dn = args.in[17];
    unsigned char* ws = args.ws; float* out = args.out;
    bf16_t* WTin = (bf16_t*)(ws + WS_WIN); bf16_t* WTout = (bf16_t*)(ws + WS_WOUT); bf16_t* WTup = (bf16_t*)(ws + WS_WUP); bf16_t* WTdn = (bf16_t*)(ws + WS_WDN);
    float* SSQ = (float*)(ws + WS_SSQ); float* RS1 = (float*)(ws + WS_RS1);
    bf16_t* XN = (bf16_t*)(ws + WS_XN); bf16_t* PROJ = (bf16_t*)(ws + WS_PROJ); bf16_t* MIX = (bf16_t*)(ws + WS_MIX);
    float* ATT = (float*)(ws + WS_ATT); float* HG = (float*)(ws + WS_HG); bf16_t* X1B = (bf16_t*)(ws + WS_X1B); bf16_t* GB = (bf16_t*)(ws + WS_G);
    float* DL = (float*)(ws + WS_DL);
    float* UL = (float*)(ws + WS_UL); float* U01 = (float*)(ws + WS_U01); float* V01 = (float*)(ws + WS_V01);

    unsigned* ctl = (unsigned*)ws;
    if (tid < 16) ((volatile LAS unsigned*)(lds + LDS_MISC))[tid] = 0u;
    __syncthreads();
    if (args.ws == nullptr) grid.sync();
    const XcdBarrier bar = xcd_barrier_post(ctl + CW_BAR, (volatile LAS unsigned*)(lds + LDS_MISC));
    {
        LAS float* scr = (LAS float*)(lds + wave * 16384);
        constexpr int I_IN = (D / 64) * (NCOLS / 32);
        f32x4 wv[4];
#pragma unroll
        for (int j = 0; j < 4; ++j) wv[j] = ((const f32x4*)ln1w)[lane + 64 * j];
        f32x4 v0[4], v1[4];
        { const f32x4* xr0 = (const f32x4*)(x + (size_t)gw * D); const f32x4* xr1 = (const f32x4*)(x + (size_t)(gw + NGW) * D);
#pragma unroll
          for (int j = 0; j < 4; ++j) { v0[j] = xr0[lane + 64 * j]; v1[j] = xr1[lane + 64 * j]; } }
        for (int it = gw; it < I_IN; it += NGW) p0_transpose_item<2>(w_in, D, NCOLS, WTin, nullptr, scr, it, lane);
        for (int row = gw; row < M; row += 2 * NGW) {
            f32x4 n0[4], n1[4];
            const int nrow = row + 2 * NGW < M ? row + 2 * NGW : row;
            { const f32x4* xr0 = (const f32x4*)(x + (size_t)nrow * D); const f32x4* xr1 = (const f32x4*)(x + (size_t)(nrow + NGW) * D);
#pragma unroll
              for (int j = 0; j < 4; ++j) { n0[j] = xr0[lane + 64 * j]; n1[j] = xr1[lane + 64 * j]; } }
            float s0 = 0.f, s1 = 0.f;
#pragma unroll
            for (int j = 0; j < 4; ++j) { s0 += (v0[j].x * v0[j].x + v0[j].y * v0[j].y) + (v0[j].z * v0[j].z + v0[j].w * v0[j].w); s1 += (v1[j].x * v1[j].x + v1[j].y * v1[j].y) + (v1[j].z * v1[j].z + v1[j].w * v1[j].w); }
            const float ms0 = wave_sum(s0) * (1.f / D) + EPS, ms1 = wave_sum(s1) * (1.f / D) + EPS;
            const float r0 = rsqrtf(ms0), r1 = rsqrtf(ms1);
            if (lane == 0) { RS1[row] = ms0 * r0; RS1[row + NGW] = ms1 * r1; }
#pragma unroll
            for (int j = 0; j < 4; ++j) {
                uint2 o; o.x = pk2(v0[j].x * r0 * wv[j].x, v0[j].y * r0 * wv[j].y); o.y = pk2(v0[j].z * r0 * wv[j].z, v0[j].w * r0 * wv[j].w);
                ((uint2*)(XN + (size_t)row * D))[lane + 64 * j] = o;
                uint2 p; p.x = pk2(v1[j].x * r1 * wv[j].x, v1[j].y * r1 * wv[j].y); p.y = pk2(v1[j].z * r1 * wv[j].z, v1[j].w * r1 * wv[j].w);
                ((uint2*)(XN + (size_t)(row + NGW) * D))[lane + 64 * j] = p; }
#pragma unroll
            for (int j = 0; j < 4; ++j) { v0[j] = n0[j]; v1[j] = n1[j]; }
        }
    }
    xcd_barrier(bar);

    {
        pg8::Gemm g{XN, WTin, M, NCOLS, D, D}; pg8::StaticOrder So; So.init(M, NCOLS, G, (int)blockIdx.x);
        pg8::EpiProj E{PROJ, qnw, knw, QSCALE, lbl, DL, hnw};
        pg8::gemm_phase<pg8::EpiProj, pg8::StaticOrder, true>(lds, g, So, E);
    }
    xcd_barrier(bar);

    {
        if (wave >= 4) __builtin_amdgcn_s_setprio(1);
        if (blockIdx.x < 64) hg::hgrn_unit(lds, PROJ, MIX, DL, hnw, (int)blockIdx.x >> 2, (int)blockIdx.x & 3, tid, lane, wave);
        __syncthreads();
        {
            const float s1 = wave_sum(lq1[lane] * lk1[lane]), s2 = wave_sum(lq2[lane] * lk2[lane]);
            const float lam = __expf(s1) - __expf(s2) + LAM_INIT;
            LAS int* qslot = (LAS int*)(lds + fa::OFF_Q);
            int u = fa::attn_run(lds, PROJ, MIX, sublnw, ctl, lam, tid, lane, wave);
            for (;;) {
                constexpr int I_OUT = (D / 64) * (D / 32), I_UP = (D / 64) * (2 * DFF / 32), I_DN = (DFF / 64) * (D / 32), NCONV = (I_OUT + I_UP + I_DN + 7) / 8;
                if (u >= 1024 + NCONV) break;
                {
                    LAS float* scr = (LAS float*)(lds + wave * 16384);
                    int lane2 = lane; asm volatile("" : "+v"(lane2));
                    int r = (u - 1024) * 8 + wave;
                    if (r < I_OUT) p0_transpose_item<0>(w_out, D, D, WTout, nullptr, scr, r, lane2);
                    else if ((r -= I_OUT) < I_UP) p0_transpose_item<1>(w_up, D, 2 * DFF, WTup, ln2w, scr, r, lane2);
                    else if ((r -= I_UP) < I_DN) p0_transpose_item<0>(w_dn, DFF, D, WTdn, nullptr, scr, r, lane2);
                }
                if (tid == 0) *qslot = (int)__hip_atomic_fetch_add(ctl, 1u, __ATOMIC_RELAXED, __HIP_MEMORY_SCOPE_AGENT);
                __syncthreads();
                u = __builtin_amdgcn_readfirstlane(*qslot);
                __syncthreads();
            }
        }
        __builtin_amdgcn_s_setprio(0);
    }
    xcd_barrier(bar);

    {
        pg8::Gemm g{MIX, WTout, M, D, D, D}; pg8::StaticOrder So; So.init(M, D, G, (int)blockIdx.x);
        pg8::EpiResid<true, false, true, true> E{X1B, nullptr, X1B, SSQ, RS1, ln1w};
        pg8::gemm_phase<pg8::EpiResid<true, false, true, true>, pg8::StaticOrder, true>(lds, g, So, E);
    }
    xcd_barrier(bar);

    {
        pg8::Gemm g{X1B, WTup, M, 2 * DFF, D, D}; pg8::StaticOrder So; So.init(M, 2 * DFF, G, (int)blockIdx.x);
        LAS float* rtab = (LAS float*)(lds + RING_BYTES + 4096);
        {
          f32x4 sv[6][4]; bool ok[6];
#pragma unroll
          for (int k = 0; k < 6; ++k) { pg8::Unit un; const int ui = (tid >> 8) + 2 * k; ok[k] = ui < 11 && So.next(ui, un);
              const f32x4* sp = (const f32x4*)(SSQ + (size_t)((ok[k] ? un.pm : 0) * 256 + (tid & 255)) * 16);
#pragma unroll
              for (int q = 0; q < 4; ++q) sv[k][q] = sp[q]; }
#pragma unroll
          for (int k = 0; k < 6; ++k) if (ok[k]) {
              const f32x4 a = sv[k][0], b_ = sv[k][1], c_ = sv[k][2], d_ = sv[k][3];
              const float s = ((a[0] + a[1]) + (a[2] + a[3])) + ((b_[0] + b_[1]) + (b_[2] + b_[3])) + ((c_[0] + c_[1]) + (c_[2] + c_[3])) + ((d_[0] + d_[1]) + (d_[2] + d_[3]));
              rtab[tid + NTHREADS * k] = rsqrtf(s * (1.f / 1024.f) + EPS); }
          __syncthreads(); }
        pg8::EpiConvGlu E{GB, rtab, cw, cb, UL, U01, V01, (LAS float*)(lds + RING_BYTES)};
        pg8::gemm_phase<pg8::EpiConvGlu, pg8::StaticOrder, true>(lds, g, So, E);
    }
    xcd_barrier(bar);

    {
        pg8::Gemm g{GB, WTdn, M, D, DFF, DFF}; pg8::StaticOrder So; So.init(M, D, G, (int)blockIdx.x);
        pg8::Unit un;
        for (int ui = 0; So.next(ui, un); ++ui) {
            const int pm = un.pm;
            if ((pm & 7) == 0) continue;
            for (int e = tid; e < 2 * DFF; e += NTHREADS) {
                const int j = e / DFF, ch = e - j * DFF;
                const float ua = UL[((size_t)(pm - 1) * 2 + 0) * DFF + ch], ub = UL[((size_t)(pm - 1) * 2 + 1) * DFF + ch];
                const float u0 = U01[((size_t)pm * 2 + 0) * DFF + ch], u1 = U01[((size_t)pm * 2 + 1) * DFF + ch];
                const float um2 = j ? ub : ua, um1 = j ? u0 : ub, uc = j ? u1 : u0;
                const float c = cb[ch] + cw[ch] * um2 + cw[DFF + ch] * um1 + cw[2 * DFF + ch] * uc;
                GB[((size_t)pm * 256 + j) * DFF + ch] = (bf16_t)f2bf(c * sigmoidf_(c) * V01[((size_t)pm * 2 + j) * DFF + ch]);
            }
        }
        asm volatile("s_waitcnt vmcnt(0)" ::: "memory");
        __syncthreads();
        pg8::EpiResid<true, true, false> E{X1B, out, nullptr, nullptr, nullptr, nullptr};
        pg8::gemm_phase<pg8::EpiResid<true, true, false>, pg8::StaticOrder, true>(lds, g, So, E);
    }
}

extern "C" void kernel_launch(void* const* d_in, const int* in_sizes, int n_in, void* d_out, int out_size, void* d_ws, size_t ws_size, hipStream_t stream) {
    static int grid_blocks = 0;
    if (grid_blocks == 0) {
        if (n_in != 18 || in_sizes[0] != M * D || out_size != M * D || ws_size < WS_NEED) { fprintf(stderr, "kernel_launch: unexpected shapes: n_in %d in0 %d out %d ws %zu\n", n_in, n_in > 0 ? in_sizes[0] : -1, out_size, ws_size); grid_blocks = -1; return; }
        int dev = 0, cus = 0, per_cu = 0;
        if (hipGetDevice(&dev) != hipSuccess || hipDeviceGetAttribute(&cus, hipDeviceAttributeMultiprocessorCount, dev) != hipSuccess) { grid_blocks = -1; return; }
        if (hipFuncSetAttribute((const void*)mega_fwd, hipFuncAttributeMaxDynamicSharedMemorySize, LDS_BYTES) != hipSuccess) { fprintf(stderr, "kernel_launch: hipFuncSetAttribute failed\n"); grid_blocks = -1; return; }
        if (hipOccupancyMaxActiveBlocksPerMultiprocessor(&per_cu, (const void*)mega_fwd, NTHREADS, LDS_BYTES) != hipSuccess || per_cu < 1) { fprintf(stderr, "kernel_launch: occupancy query failed (%d)\n", per_cu); (void)hipGetLastError(); grid_blocks = -1; return; }
        grid_blocks = cus * (per_cu > 1 ? 1 : per_cu);
    }
    if (grid_blocks < 0) return;
    if (hipMemsetAsync(d_ws, 0, 65536, stream) != hipSuccess) { fprintf(stderr, "kernel_launch: hipMemsetAsync failed\n"); return; }
    Args a{};
    for (int i = 0; i < 18; ++i) a.in[i] = (const float*)d_in[i];
    a.out = (float*)d_out; a.ws = (unsigned char*)d_ws;
    void* kargs[] = {&a};
    hipError_t e = hipLaunchCooperativeKernel((const void*)mega_fwd, dim3(grid_blocks), dim3(NTHREADS), kargs, LDS_BYTES, stream);
    if (e != hipSuccess) fprintf(stderr, "cooperative launch failed: %s (grid %d)\n", hipGetErrorString(e), grid_blocks);
}
```
